# Optimizing an MI355X kernel written in HIP

```python
import math
import jax, jax.numpy as jnp
from jax import lax
import numpy as np

D_MODEL = 1024
BATCH = 8
SEQ = 2048
DEPTH = 4

N_MIXERS = 2
EXPAND = 2
D_INNER = EXPAND * D_MODEL
EPS = 1e-6
GLA_HEADS = 4
GLA_KEY_DIM = D_MODEL // 2
GLA_DK = GLA_KEY_DIM // GLA_HEADS
GLA_DV = D_INNER // GLA_HEADS
GLA_GATE_RANK = 16
GLA_GATE_TAU = 16.0
GLA_CHUNK = 64
GLA_IN = 2 * GLA_KEY_DIM + 2 * D_INNER + GLA_GATE_RANK
S5_GROUP = 16
S5_GROUPS = D_INNER // S5_GROUP
S5_STATE = 64
S5_DT_MIN = 1e-3
S5_DT_MAX = 1e-1
S5_IN = 2 * D_INNER
N_GLA = (DEPTH + 1) // 2
N_S5 = DEPTH // 2

kernel_name = "hybrid_gla_s5_interleaved"


def _rmsnorm(x, g):
    x32 = x.astype(jnp.float32)
    y = x32 * lax.rsqrt(jnp.mean(x32 * x32, axis=-1, keepdims=True) + EPS) * g.astype(jnp.float32)
    return y.astype(x.dtype)


def _gla_mixer(h, w_in, w_gate_up, b_gate, head_gain, w_out):
    bsz, seqlen, _ = h.shape
    n_chunks = seqlen // GLA_CHUNK
    f32 = jnp.float32
    proj = h @ w_in
    q, k, v, z, r = jnp.split(
        proj,
        [GLA_KEY_DIM, 2 * GLA_KEY_DIM, 2 * GLA_KEY_DIM + D_INNER, 2 * GLA_KEY_DIM + 2 * D_INNER],
        axis=-1)
    log_a = jax.nn.log_sigmoid((r @ w_gate_up + b_gate).astype(f32)) / GLA_GATE_TAU

    def to_chunks(t, d):
        return t.astype(f32).reshape(bsz, n_chunks, GLA_CHUNK, GLA_HEADS, d).transpose(0, 3, 1, 2, 4)

    qc = to_chunks(q, GLA_DK) * (GLA_DK ** -0.5)
    kc = to_chunks(k, GLA_DK)
    vc = to_chunks(v, GLA_DV)
    bcum = jnp.cumsum(to_chunks(log_a, GLA_DK), axis=3)
    b_last = bcum[:, :, :, -1:, :]

    q_g = qc * jnp.exp(bcum)
    k_g = kc * jnp.exp(-bcum)
    k_end = kc * jnp.exp(b_last - bcum)

    causal = jnp.tril(jnp.ones((GLA_CHUNK, GLA_CHUNK), dtype=bool))
    att = jnp.einsum('bhncd,bhnsd->bhncs', q_g, k_g)
    att = jnp.where(causal, att, 0.0)
    o_intra = jnp.einsum('bhncs,bhnse->bhnce', att, vc)

    kv_chunk = jnp.einsum('bhnsd,bhnse->bhnde', k_end, vc)
    decay_chunk = jnp.exp(b_last[:, :, :, 0, :])

    def step(state, inp):
        dec, kv = inp
        return dec[..., None] * state + kv, state

    s0 = jnp.zeros((bsz, GLA_HEADS, GLA_DK, GLA_DV), f32)
    _, s_prev = lax.scan(step, s0, (jnp.moveaxis(decay_chunk, 2, 0), jnp.moveaxis(kv_chunk, 2, 0)))
    s_prev = jnp.moveaxis(s_prev, 0, 2)
    o = o_intra + jnp.einsum('bhncd,bhnde->bhnce', q_g, s_prev)

    o = o.transpose(0, 2, 3, 1, 4).reshape(bsz, seqlen, GLA_HEADS, GLA_DV)
    o = o * lax.rsqrt(jnp.mean(o * o, axis=-1, keepdims=True) + EPS) * head_gain.astype(f32)
    o = o.reshape(bsz, seqlen, D_INNER) * jax.nn.silu(z.astype(f32))
    return o.astype(h.dtype) @ w_out


def _s5_mixer(h, w_in, lam_re, lam_im, log_dt, b_re, b_im, c_re, c_im, d_skip, w_glu, b_glu, w_out):
    bsz, seqlen, _ = h.shape
    f32 = jnp.float32
    proj = h @ w_in
    u, z = jnp.split(proj, [D_INNER], axis=-1)
    u32 = u.astype(f32).reshape(bsz, seqlen, S5_GROUPS, S5_GROUP)

    lam = lax.complex(lam_re.astype(f32), lam_im.astype(f32))
    dt = jnp.exp(log_dt.astype(f32))[:, None]
    lam_bar = jnp.exp(lam * dt)
    b_coef = (lam_bar - 1.0) / lam
    b_cplx = lax.complex(b_re.astype(f32), b_im.astype(f32))
    b_bar = b_coef[..., None] * b_cplx
    bu = lax.complex(jnp.einsum('blgi,gpi->blgp', u32, jnp.real(b_bar)),
                     jnp.einsum('blgi,gpi->blgp', u32, jnp.imag(b_bar)))
    a = jnp.broadcast_to(lam_bar[None, None], (1, seqlen, S5_GROUPS, S5_STATE))

    def combine(left, right):
        a_l, b_l = left
        a_r, b_r = right
        return a_l * a_r, a_r * b_l + b_r

    _, states = lax.associative_scan(combine, (a, bu), axis=1)
    y = (jnp.einsum('blgp,gip->blgi', jnp.real(states), c_re.astype(f32))
         - jnp.einsum('blgp,gip->blgi', jnp.imag(states), c_im.astype(f32)))
    y = y + d_skip.astype(f32) * u32
    y = jax.nn.gelu(y.reshape(bsz, seqlen, D_INNER))
    y = y * jax.nn.sigmoid(y @ w_glu.astype(f32) + b_glu.astype(f32))
    y = y * jax.nn.silu(z.astype(f32))
    return y.astype(h.dtype) @ w_out


def setup_inputs(seed: int = 0) -> dict:
    key = jax.random.key(seed)
    ks = jax.random.split(key, 24)
    nrm = jax.random.normal
    f32 = jnp.float32
    x = nrm(ks[0], (BATCH, SEQ, D_MODEL), f32)
    gla_norm = 1.0 + 0.01 * nrm(ks[1], (N_GLA, D_MODEL), f32)
    gla_w_in = nrm(ks[2], (N_GLA, D_MODEL, GLA_IN), f32) * D_MODEL ** -0.5
    gla_w_gate_up = nrm(ks[3], (N_GLA, GLA_GATE_RANK, GLA_KEY_DIM), f32) * GLA_GATE_RANK ** -0.5
    gla_b_gate = 0.1 * nrm(ks[4], (N_GLA, GLA_KEY_DIM), f32)
    gla_head_gain = 1.0 + 0.01 * nrm(ks[5], (N_GLA, GLA_DV), f32)
    gla_w_out = nrm(ks[6], (N_GLA, D_INNER, D_MODEL), f32) * D_INNER ** -0.5
    s5_norm = 1.0 + 0.01 * nrm(ks[7], (N_S5, D_MODEL), f32)
    s5_w_in = nrm(ks[8], (N_S5, D_MODEL, S5_IN), f32) * D_MODEL ** -0.5
    s5_lam_re = -0.5 + 1e-3 * nrm(ks[9], (N_S5, S5_GROUPS, S5_STATE), f32)
    s5_lam_im = (math.pi * jnp.arange(S5_STATE, dtype=f32))[None, None, :] \
        + 1e-3 * nrm(ks[10], (N_S5, S5_GROUPS, S5_STATE), f32)
    s5_log_dt = jax.random.uniform(ks[11], (N_S5, S5_GROUPS), f32,
                                   minval=math.log(S5_DT_MIN), maxval=math.log(S5_DT_MAX))
    s5_b_re = nrm(ks[12], (N_S5, S5_GROUPS, S5_STATE, S5_GROUP), f32) * (2 * S5_GROUP) ** -0.5
    s5_b_im = nrm(ks[13], (N_S5, S5_GROUPS, S5_STATE, S5_GROUP), f32) * (2 * S5_GROUP) ** -0.5
    s5_c_re = nrm(ks[14], (N_S5, S5_GROUPS, S5_GROUP, S5_STATE), f32) * S5_STATE ** -0.5
    s5_c_im = nrm(ks[15], (N_S5, S5_GROUPS, S5_GROUP, S5_STATE), f32) * S5_STATE ** -0.5
    s5_d = nrm(ks[16], (N_S5, S5_GROUPS, S5_GROUP), f32)
    s5_w_glu = nrm(ks[17], (N_S5, D_INNER, D_INNER), f32) * D_INNER ** -0.5
    s5_b_glu = 0.01 * nrm(ks[18], (N_S5, D_INNER), f32)
    s5_w_out = nrm(ks[19], (N_S5, D_INNER, D_MODEL), f32) * D_INNER ** -0.5
    final_norm = 1.0 + 0.01 * nrm(ks[20], (D_MODEL,), f32)
    return {
        "x": x,
        "gla_norm": gla_norm, "gla_w_in": gla_w_in, "gla_w_gate_up": gla_w_gate_up,
        "gla_b_gate": gla_b_gate, "gla_head_gain": gla_head_gain, "gla_w_out": gla_w_out,
        "s5_norm": s5_norm, "s5_w_in": s5_w_in, "s5_lam_re": s5_lam_re, "s5_lam_im": s5_lam_im,
        "s5_log_dt": s5_log_dt, "s5_b_re": s5_b_re, "s5_b_im": s5_b_im,
        "s5_c_re": s5_c_re, "s5_c_im": s5_c_im, "s5_d": s5_d,
        "s5_w_glu": s5_w_glu, "s5_b_glu": s5_b_glu, "s5_w_out": s5_w_out,
        "final_norm": final_norm,
    }


def reference(x, gla_norm, gla_w_in, gla_w_gate_up, gla_b_gate, gla_head_gain, gla_w_out,
              s5_norm, s5_w_in, s5_lam_re, s5_lam_im, s5_log_dt, s5_b_re, s5_b_im,
              s5_c_re, s5_c_im, s5_d, s5_w_glu, s5_b_glu, s5_w_out, final_norm):
    for i in range(DEPTH):
        j = i // N_MIXERS
        if i % N_MIXERS == 0:
            h = _rmsnorm(x, gla_norm[j])
            out = _gla_mixer(h, gla_w_in[j], gla_w_gate_up[j], gla_b_gate[j],
                             gla_head_gain[j], gla_w_out[j])
        else:
            h = _rmsnorm(x, s5_norm[j])
            out = _s5_mixer(h, s5_w_in[j], s5_lam_re[j], s5_lam_im[j], s5_log_dt[j],
                            s5_b_re[j], s5_b_im[j], s5_c_re[j], s5_c_im[j], s5_d[j],
                            s5_w_glu[j], s5_b_glu[j], s5_w_out[j])
        x = x + out.astype(x.dtype)
    return _rmsnorm(x, final_norm)
```

```cpp
#include <hip/hip_runtime.h>
#include <hip/hip_cooperative_groups.h>
#include <cstdio>
namespace cg = cooperative_groups;

#define LAS __attribute__((address_space(3)))
typedef unsigned short bf16_t;
typedef short bf16x8 __attribute__((ext_vector_type(8)));
typedef float f32x4 __attribute__((ext_vector_type(4)));
typedef float f32x2 __attribute__((ext_vector_type(2)));
typedef unsigned u32x4 __attribute__((ext_vector_type(4)));
typedef unsigned u32x2 __attribute__((ext_vector_type(2)));

constexpr int MTOK = 16384, DM = 1024, DI = 2048, SEQ = 2048;
constexpr int GLA_IN = 5136, GLA_NP = 5376;
constexpr float EPS = 1e-6f;
constexpr int LDS_BYTES = 131072;

constexpr size_t WS_WGLA_IN = 0;
constexpr size_t WS_WGLA_OUT = WS_WGLA_IN + (size_t)GLA_NP * 1024 * 2;
constexpr size_t WS_WS5_IN = WS_WGLA_OUT + (size_t)1024 * 2048 * 2;
constexpr size_t WS_WS5_GLU = WS_WS5_IN + (size_t)4096 * 1024 * 2;
constexpr size_t WS_WS5_OUT = WS_WS5_GLU + (size_t)2048 * 2048 * 2;
constexpr size_t WS_XB = WS_WS5_OUT + (size_t)1024 * 2048 * 2;
constexpr size_t WS_PA = WS_XB + (size_t)MTOK * 1024 * 2;
constexpr size_t WS_QK = WS_PA + (size_t)MTOK * 4096 * 2;
constexpr size_t WS_RSS = WS_QK + (size_t)MTOK * 1280 * 2;
constexpr size_t WS_DEC = WS_RSS + (size_t)MTOK * 16 * 4;
constexpr size_t WS_SSQ = WS_DEC + (size_t)1024 * 128 * 4;
constexpr size_t WS_END = WS_SSQ + (size_t)MTOK * 64 * 4;

__device__ __forceinline__ float bf2f(bf16_t b) { return __uint_as_float(((unsigned)b) << 16); }
__device__ __forceinline__ float bflo(unsigned w) { return __uint_as_float(w << 16); }
__device__ __forceinline__ float bfhi(unsigned w) { return __uint_as_float(w & 0xffff0000u); }
__device__ __forceinline__ unsigned cvt_pk_bf16(float lo, float hi) { unsigned r; asm volatile("v_cvt_pk_bf16_f32 %0, %1, %2" : "=v"(r) : "v"(lo), "v"(hi)); return r; }
__device__ __forceinline__ bf16_t f2bf(float f) { return (bf16_t)(cvt_pk_bf16(f, 0.f) & 0xffffu); }
__device__ __forceinline__ float sigmoidf_(float x) { return 1.0f / (1.0f + __expf(-x)); }
__device__ __forceinline__ float wave_sum(float v) {
#pragma unroll
    for (int o = 32; o > 0; o >>= 1) v += __shfl_xor(v, o);
    return v;
}

namespace pg8 {
constexpr int BM = 256, BK = 64, HALF = 128, HTB = HALF * BK * 2, STAGE_BYTES = 8 * HTB, NXCD = 8, WGM = 8;
__host__ __device__ __forceinline__ int lds_byte(int r, int c) { const int st = (r >> 4) * 2 + (c >> 5), rr = r & 15, cc = c & 31, ob = rr * 64 + cc * 2; return st * 1024 + (ob ^ (((ob >> 9) & 1) << 5)); }
__host__ __device__ __forceinline__ void stage_rc(int b, int& R, int& C) { const int st = b / 1024, sb = b % 1024, swz = sb ^ (((sb >> 9) & 1) << 5); R = (st >> 1) * 16 + swz / 64; C = (st & 1) * 32 + (swz % 64) / 2; }
__host__ __device__ __forceinline__ int perm32(int rho) { const int n = rho >> 4, i = rho & 15; return 8 * (i >> 2) + 4 * n + (i & 3); }

struct Unit { int pm, pn; };
struct Gemm { const bf16_t* A; const bf16_t* Bt; int M, N, K, lda; };

struct StaticOrder {
    int nM, nN, nwg, G, c;
    __host__ __device__ void init(int M, int N, int G_, int c_) { nM = M / BM; nN = N / BM; nwg = nM * nN; G = G_; c = c_; }
    __host__ __device__ bool next(int i, Unit& u) const {
        const long L = (long)i * G + c; if (L >= nwg) return false;
        int wgid = (int)L; { const int q = nwg / NXCD, r = nwg % NXCD, xcd = wgid % NXCD, off = wgid / NXCD; wgid = (xcd < r ? xcd * (q + 1) : r * (q + 1) + (xcd - r) * q) + off; }
        const int nig = WGM * nN, gid = wgid / nig, fm = gid * WGM, gsz = (nM - fm) < WGM ? (nM - fm) : WGM;
        u.pm = fm + ((wgid % nig) % gsz); u.pn = (wgid % nig) / gsz; return true;
    }
};

template <class Epi>
__device__ __forceinline__ void gemm_phase(LAS unsigned char* lds, const Gemm g, const StaticOrder& S, const Epi& E) {
    int tid_ = threadIdx.x; asm volatile("" : "+v"(tid_));
    const int tid = tid_, wid = __builtin_amdgcn_readfirstlane(tid >> 6), lane = tid & 63, wr = wid >> 2, wc = wid & 3, fr = lane & 15, fq = lane >> 4;
    const int K = g.K, nt = K / BK, lda = g.lda;
    unsigned voffA[2], voffB[2];
#pragma unroll
    for (int i = 0; i < 2; ++i) { int R, C; stage_rc(tid * 16 + i * 8192, R, C); const int Rb = Epi::PERM ? ((R & ~31) + perm32(R & 31)) : R;
        voffA[i] = (unsigned)(R * lda + C) * 2u; voffB[i] = (unsigned)(Rb * K + C) * 2u; }
    const size_t kstep = (size_t)(BK * 2);
    const size_t hstepA = (size_t)HALF * lda * 2, hstepB = (size_t)HALF * K * 2;
    const size_t tstepA = 2 * hstepA, tstepB = 2 * hstepB;
    const unsigned ldsw = (unsigned)wid * 1024u;
    const int aoff = lds_byte(wr * 64 + fr, fq * 8), boff = lds_byte(wc * 32 + fr, fq * 8);
#define PG8_SA(b, h) (((b) * 2 + (h)) * HTB)
#define PG8_SB(b, h) ((4 + (b) * 2 + (h)) * HTB)
#define PG8_STAGE(bufoff, gbase, voff) do { _Pragma("unroll") for (int _i = 0; _i < 2; ++_i) \
        __builtin_amdgcn_global_load_lds((const unsigned*)((const char*)(gbase) + (voff)[_i]), (LAS unsigned*)(lds + (bufoff) + ldsw + _i * 8192), 16, 0, 0); } while (0)
#define PG8_LDA(dst, b, h) do { _Pragma("unroll") for (int m = 0; m < 4; ++m) _Pragma("unroll") for (int k = 0; k < 2; ++k) dst[m][k] = *(const LAS bf16x8*)(lds + PG8_SA(b, h) + aoff + m * 2048 + k * 1024); } while (0)
#define PG8_LDB(dst, b, h) do { _Pragma("unroll") for (int n = 0; n < 2; ++n) _Pragma("unroll") for (int k = 0; k < 2; ++k) dst[n][k] = *(const LAS bf16x8*)(lds + PG8_SB(b, h) + boff + n * 2048 + k * 1024); } while (0)
#define PG8_MMA(ai, bj, At, Bt) do { __builtin_amdgcn_s_setprio(1); _Pragma("unroll") for (int m = 0; m < 4; ++m) _Pragma("unroll") for (int n = 0; n < 2; ++n) _Pragma("unroll") for (int k = 0; k < 2; ++k) \
        acc[ai][bj][m][n] = __builtin_amdgcn_mfma_f32_16x16x32_bf16(Bt[n][k], At[m][k], acc[ai][bj][m][n], 0, 0, 0); __builtin_amdgcn_s_setprio(0); } while (0)
#define PG8_WAIT_V(n) asm volatile("s_waitcnt vmcnt(" #n ")" ::: "memory")
#define PG8_WAIT_L(n) asm volatile("s_waitcnt lgkmcnt(" #n ")" ::: "memory")
#define PG8_BAR __builtin_amdgcn_s_barrier()
#define PG8_SCHED __builtin_amdgcn_sched_barrier(0)
    Unit cur, nxt; int ui = 0;
    if (!S.next(0, cur)) return;
    f32x4 acc[2][2][4][2];
#pragma unroll
    for (int a = 0; a < 2; ++a)
#pragma unroll
        for (int b = 0; b < 2; ++b)
#pragma unroll
            for (int m = 0; m < 4; ++m)
#pragma unroll
                for (int n = 0; n < 2; ++n) acc[a][b][m][n] = (f32x4){0.f, 0.f, 0.f, 0.f};
    bf16x8 At[4][2], B0[2][2], B1[2][2];
    const char* cA = (const char*)g.A + (size_t)cur.pm * tstepA; const char* cB = (const char*)g.Bt + (size_t)cur.pn * tstepB;
    PG8_STAGE(PG8_SB(0, 0), cB, voffB); PG8_STAGE(PG8_SA(0, 0), cA, voffA); PG8_STAGE(PG8_SB(0, 1), cB + hstepB, voffB); PG8_STAGE(PG8_SA(0, 1), cA + hstepA, voffA);
    if (wr == 1) PG8_BAR;
    PG8_WAIT_V(4); PG8_BAR;
    PG8_STAGE(PG8_SB(1, 0), cB + kstep, voffB); PG8_STAGE(PG8_SA(1, 0), cA + kstep, voffA); PG8_STAGE(PG8_SB(1, 1), cB + hstepB + kstep, voffB);
    PG8_WAIT_V(6); PG8_BAR;
    for (;;) {
        const bool has_next = S.next(ui + 1, nxt);
        const char* nA = has_next ? (const char*)g.A + (size_t)nxt.pm * tstepA : cA; const char* nB = has_next ? (const char*)g.Bt + (size_t)nxt.pn * tstepB : cB;
        for (int t = 0; t < nt; t += 2) {
            const bool last = (t == nt - 2);
            const char* a1 = cA + (size_t)(t + 1) * kstep;
            const char* a2 = last ? nA : cA + (size_t)(t + 2) * kstep; const char* b2 = last ? nB : cB + (size_t)(t + 2) * kstep;
            const char* a3 = a2 + kstep; const char* b3 = b2 + kstep;
            PG8_LDB(B0, 0, 0); PG8_SCHED; PG8_LDA(At, 0, 0); PG8_STAGE(PG8_SA(1, 1), a1 + hstepA, voffA);
            PG8_WAIT_L(8); PG8_BAR; PG8_WAIT_L(0); PG8_MMA(0, 0, At, B0); PG8_BAR; PG8_SCHED;
            PG8_LDB(B1, 0, 1); PG8_STAGE(PG8_SB(0, 0), b2, voffB);
            PG8_BAR; PG8_WAIT_L(0); PG8_MMA(0, 1, At, B1); PG8_BAR;
            PG8_LDA(At, 0, 1); PG8_STAGE(PG8_SA(0, 0), a2, voffA);
            PG8_BAR; PG8_WAIT_L(0); PG8_MMA(1, 0, At, B0); PG8_BAR; PG8_SCHED;
            PG8_STAGE(PG8_SB(0, 1), b2 + hstepB, voffB);
            PG8_WAIT_V(6); PG8_BAR; PG8_MMA(1, 1, At, B1); PG8_BAR;
            PG8_LDB(B0, 1, 0); PG8_SCHED; PG8_LDA(At, 1, 0); PG8_STAGE(PG8_SA(0, 1), a2 + hstepA, voffA);
            PG8_WAIT_L(8); PG8_BAR; PG8_WAIT_L(0); PG8_MMA(0, 0, At, B0); PG8_BAR; PG8_SCHED;
            PG8_LDB(B1, 1, 1); PG8_STAGE(PG8_SB(1, 0), b3, voffB);
            PG8_BAR; PG8_WAIT_L(0); PG8_MMA(0, 1, At, B1); PG8_BAR;
            PG8_LDA(At, 1, 1); PG8_STAGE(PG8_SA(1, 0), a3, voffA);
            PG8_BAR; PG8_WAIT_L(0); PG8_MMA(1, 0, At, B0); PG8_BAR; PG8_SCHED;
            PG8_STAGE(PG8_SB(1, 1), b3 + hstepB, voffB);
            PG8_WAIT_V(6); PG8_BAR; PG8_MMA(1, 1, At, B1); PG8_BAR;
        }
        E(acc, cur, wr, wc, fr, fq);
        if (!has_next) break;
#pragma unroll
        for (int a = 0; a < 2; ++a)
#pragma unroll
            for (int b = 0; b < 2; ++b)
#pragma unroll
                for (int m = 0; m < 4; ++m)
#pragma unroll
                    for (int n = 0; n < 2; ++n) acc[a][b][m][n] = (f32x4){0.f, 0.f, 0.f, 0.f};
        cur = nxt; cA = nA; cB = nB; ++ui;
    }
    PG8_WAIT_V(0);
    if (wr == 0) PG8_BAR;
    PG8_BAR;
#undef PG8_SA
#undef PG8_SB
#undef PG8_STAGE
#undef PG8_LDA
#undef PG8_LDB
#undef PG8_MMA
#undef PG8_WAIT_V
#undef PG8_WAIT_L
#undef PG8_BAR
#undef PG8_SCHED
}
}

__device__ __forceinline__ float row_rs(const float* rowss, int r) {
    const f32x4* rp = (const f32x4*)(rowss + (size_t)r * 16);
    const f32x4 s = (rp[0] + rp[1]) + (rp[2] + rp[3]);
    return rsqrtf(((s[0] + s[1]) + (s[2] + s[3])) * (1.0f / 1024.0f) + EPS);
}

struct EpiProj {
    static constexpr bool PERM = true;
    bf16_t* PA; bf16_t* QK; const float* rowss; int lo, hi;
    __device__ __forceinline__ void operator()(const f32x4 (&acc)[2][2][4][2], const pg8::Unit& u, int wr, int wc, int fr, int fq) const {
        bf16_t* base; int ld, colt;
        if (u.pn >= lo && u.pn < hi) { base = PA; ld = 4096; colt = (u.pn - lo) * 256; }
        else { base = QK; ld = 1280; colt = (u.pn < lo ? u.pn : u.pn - (hi - lo)) * 256; }
        const int row0 = u.pm * 256 + wr * 64 + fr, col0 = colt + wc * 32 + 8 * fq;
#pragma unroll
        for (int ai = 0; ai < 2; ++ai)
#pragma unroll
            for (int m = 0; m < 4; ++m) {
                const int r = row0 + ai * 128 + m * 16;
                const float rs = row_rs(rowss, r);
                bf16_t* rowp = base + (size_t)r * ld + col0;
#pragma unroll
                for (int bj = 0; bj < 2; ++bj) {
                    const f32x4 v0 = acc[ai][bj][m][0] * rs, v1 = acc[ai][bj][m][1] * rs;
                    u32x4 w; w.x = cvt_pk_bf16(v0[0], v0[1]); w.y = cvt_pk_bf16(v0[2], v0[3]); w.z = cvt_pk_bf16(v1[0], v1[1]); w.w = cvt_pk_bf16(v1[2], v1[3]);
                    *(u32x4*)(rowp + bj * 128) = w;
                }
            }
    }
};

struct EpiOut {
    static constexpr bool PERM = false;
    const float* base; float* out; bf16_t* xb; float* rowss;
    __device__ __forceinline__ void operator()(const f32x4 (&acc)[2][2][4][2], const pg8::Unit& u, int wr, int wc, int fr, int fq) const {
        const int row0 = u.pm * 256 + wr * 64 + fr, col0 = u.pn * 256 + wc * 32 + 4 * fq;
#pragma unroll
        for (int ai = 0; ai < 2; ++ai)
#pragma unroll
            for (int m = 0; m < 4; ++m) {
                const int r = row0 + ai * 128 + m * 16;
                const size_t off = (size_t)r * 1024 + col0;
                float ss = 0.f;
#pragma unroll
                for (int bj = 0; bj < 2; ++bj)
#pragma unroll
                    for (int n = 0; n < 2; ++n) {
                        const f32x4 b = *(const f32x4*)(base + off + bj * 128 + n * 16);
                        const f32x4 o = b + acc[ai][bj][m][n];
                        *(f32x4*)(out + off + bj * 128 + n * 16) = o;
                        ss += (o[0] * o[0] + o[1] * o[1]) + (o[2] * o[2] + o[3] * o[3]);
                        u32x2 w; w.x = cvt_pk_bf16(o[0], o[1]); w.y = cvt_pk_bf16(o[2], o[3]);
                        *(u32x2*)(xb + off + bj * 128 + n * 16) = w;
                    }
                ss += __shfl_xor(ss, 16); ss += __shfl_xor(ss, 32);
                if (fq == 0) rowss[(size_t)r * 16 + u.pn * 4 + wc] = ss;
            }
    }
};

struct EpiGlu {
    static constexpr bool PERM = true;
    bf16_t* PA; const float* bias;
    __device__ __forceinline__ void operator()(const f32x4 (&acc)[2][2][4][2], const pg8::Unit& u, int wr, int wc, int fr, int fq) const {
        const int row0 = u.pm * 256 + wr * 64 + fr, col0 = u.pn * 256 + wc * 32 + 8 * fq;
        f32x4 bv[2][2];
#pragma unroll
        for (int bj = 0; bj < 2; ++bj)
#pragma unroll
            for (int n = 0; n < 2; ++n) bv[bj][n] = *(const f32x4*)(bias + col0 + bj * 128 + 4 * n);
#pragma unroll
        for (int ai = 0; ai < 2; ++ai)
#pragma unroll
            for (int m = 0; m < 4; ++m) {
                const int r = row0 + ai * 128 + m * 16;
                bf16_t* rowp = PA + (size_t)r * 4096 + col0;
#pragma unroll
                for (int bj = 0; bj < 2; ++bj) {
                    const u32x4 yv = *(const u32x4*)(rowp + bj * 128);
                    const u32x4 zv = *(const u32x4*)(rowp + 2048 + bj * 128);
                    const f32x4 s0 = acc[ai][bj][m][0] + bv[bj][0], s1 = acc[ai][bj][m][1] + bv[bj][1];
                    float o[8];
                    const unsigned yw[4] = {yv.x, yv.y, yv.z, yv.w}, zw[4] = {zv.x, zv.y, zv.z, zv.w};
#pragma unroll
                    for (int k = 0; k < 4; ++k) {
                        const float sa = (k < 2) ? s0[2 * k] : s1[2 * k - 4], sb = (k < 2) ? s0[2 * k + 1] : s1[2 * k - 3];
                        const float ya = bflo(yw[k]), yb = bfhi(yw[k]), za = bflo(zw[k]), zb = bfhi(zw[k]);
                        o[2 * k] = ya * sigmoidf_(sa) * (za * sigmoidf_(za));
                        o[2 * k + 1] = yb * sigmoidf_(sb) * (zb * sigmoidf_(zb));
                    }
                    u32x4 w; w.x = cvt_pk_bf16(o[0], o[1]); w.y = cvt_pk_bf16(o[2], o[3]); w.z = cvt_pk_bf16(o[4], o[5]); w.w = cvt_pk_bf16(o[6], o[7]);
                    *(u32x4*)(rowp + 2048 + bj * 128) = w;
                }
            }
    }
};

__device__ __attribute__((noinline)) void convert_wt(LAS unsigned char* lds, const float* W, const float* gain, bf16_t* Wt, int K, int N, int Npad, int wg, int nwg) {
    LAS float* tile = (LAS float*)lds;
    const int tid = threadIdx.x;
    const int tilesK = K / 64, tilesN = Npad / 64;
    for (int t = wg; t < tilesK * tilesN; t += nwg) {
        const int k0 = (t % tilesK) * 64, n0 = (t / tilesK) * 64;
#pragma unroll
        for (int i = 0; i < 8; ++i) {
            const int idx = tid + i * 512, kk = idx >> 6, nn = idx & 63, n = n0 + nn;
            float v = (n < N) ? W[(size_t)(k0 + kk) * N + n] : 0.f;
            if (gain) v *= gain[k0 + kk];
            tile[nn * 65 + kk] = v;
        }
        __syncthreads();
#pragma unroll
        for (int i = 0; i < 4; ++i) {
            const int p = tid + i * 512, nn = p >> 5, kp = p & 31;
            const float a = tile[nn * 65 + 2 * kp], b = tile[nn * 65 + 2 * kp + 1];
            *(unsigned*)(Wt + (size_t)(n0 + nn) * K + k0 + 2 * kp) = cvt_pk_bf16(a, b);
        }
        __syncthreads();
    }
}

__device__ __attribute__((noinline)) void xprep(const float* x, bf16_t* xb, float* rowss, int wg, int nwg) {
    const int wave = threadIdx.x >> 6, lane = threadIdx.x & 63;
    for (int row = wg * 8 + wave; row < MTOK; row += nwg * 8) {
        const f32x4* xr = (const f32x4*)(x + (size_t)row * 1024);
        float ss = 0.f;
#pragma unroll
        for (int i = 0; i < 4; ++i) {
            const f32x4 v = xr[lane + i * 64];
            ss += (v[0] * v[0] + v[1] * v[1]) + (v[2] * v[2] + v[3] * v[3]);
            u32x2 w; w.x = cvt_pk_bf16(v[0], v[1]); w.y = cvt_pk_bf16(v[2], v[3]);
            *(u32x2*)(xb + (size_t)row * 1024 + (lane + i * 64) * 4) = w;
        }
        ss = wave_sum(ss);
        if (lane < 16) rowss[(size_t)row * 16 + lane] = (lane == 0) ? ss : 0.f;
    }
}

__device__ __attribute__((noinline)) void final_norm(float* out, const float* rowss, const float* gain, int wg, int nwg) {
    const int wave = threadIdx.x >> 6, lane = threadIdx.x & 63;
    for (int row = wg * 8 + wave; row < MTOK; row += nwg * 8) {
        const float rs = row_rs(rowss, row);
        f32x4* xr = (f32x4*)(out + (size_t)row * 1024);
        const f32x4* gp = (const f32x4*)gain;
#pragma unroll
        for (int i = 0; i < 4; ++i) { const f32x4 v = xr[lane + i * 64], g4 = gp[lane + i * 64]; xr[lane + i * 64] = v * rs * g4; }
    }
}

__device__ __attribute__((noinline)) void gla_prep(LAS unsigned char* lds, bf16_t* QK, bf16_t* KENDT, float* DEC, const float* wgu  , const float* bg  , int wg, int nwg) {
    const int tid = threadIdx.x, d = tid & 127, sq = tid >> 7;
    LAS float* rS = (LAS float*)lds;
    LAS float* tot = rS + 1024;
    for (int item = wg; item < 1024; item += nwg) {
        const int n = item & 31, h = (item >> 5) & 3, b = item >> 7;
        const size_t m0 = (size_t)b * SEQ + n * 64;
#pragma unroll
        for (int i = 0; i < 2; ++i) { const int idx = tid + i * 512, s = idx >> 4, j = idx & 15; rS[idx] = bf2f(QK[(m0 + s) * 1280 + 1024 + j]); }
        float w[16];
#pragma unroll
        for (int j = 0; j < 16; ++j) w[j] = wgu[j * 512 + h * 128 + d];
        const float bb = bg[h * 128 + d];
        __syncthreads();
        float c[16]; float run = 0.f;
#pragma unroll
        for (int i = 0; i < 16; ++i) {
            const int s = sq * 16 + i; float g = bb;
#pragma unroll
            for (int j = 0; j < 16; ++j) g += rS[s * 16 + j] * w[j];
            const float la = (fminf(g, 0.f) - log1pf(expf(-fabsf(g)))) * (1.0f / 16.0f);
            run += la; c[i] = run;
        }
        tot[sq * 128 + d] = run;
        __syncthreads();
        float off = 0.f, blast = 0.f;
#pragma unroll
        for (int qd = 0; qd < 4; ++qd) { const float t = tot[qd * 128 + d]; blast += t; if (qd < sq) off += t; }
        unsigned ke[8];
#pragma unroll
        for (int i = 0; i < 16; i += 2) {
            float kev[2];
#pragma unroll
            for (int e = 0; e < 2; ++e) {
                const int s = sq * 16 + i + e; const float bc = off + c[i + e];
                const size_t a = (m0 + s) * 1280 + h * 128 + d;
                const float q = bf2f(QK[a]), k = bf2f(QK[a + 512]);
                QK[a] = f2bf(q * expf(bc) * 0.08838834764831845f);
                QK[a + 512] = f2bf(k * expf(-bc));
                kev[e] = k * expf(blast - bc);
            }
            ke[i >> 1] = cvt_pk_bf16(kev[0], kev[1]);
        }
        u32x4* kd = (u32x4*)(KENDT + ((size_t)item * 128 + d) * 64 + sq * 16);
        kd[0] = (u32x4){ke[0], ke[1], ke[2], ke[3]}; kd[1] = (u32x4){ke[4], ke[5], ke[6], ke[7]};
        if (sq == 0) DEC[item * 128 + d] = expf(blast);
        __syncthreads();
    }
}

__device__ __attribute__((noinline)) void gla_scan(LAS unsigned char* lds, bf16_t* PA, const bf16_t* QK, const bf16_t* KENDT, const float* DEC, float* SSQ, int wg, int nwg) {
    const int tid = threadIdx.x, wave = __builtin_amdgcn_readfirstlane(tid >> 6), lane = tid & 63, fr = lane & 15, fq = lane >> 4;
    LAS bf16_t* Qs = (LAS bf16_t*)lds;
    LAS bf16_t* Ks = (LAS bf16_t*)(lds + 17408);
    LAS bf16_t* KEs = (LAS bf16_t*)(lds + 34816);
    LAS bf16_t* Vt = (LAS bf16_t*)(lds + 53248);
    LAS bf16_t* As = (LAS bf16_t*)(lds + 62464);
    LAS bf16_t* St = (LAS bf16_t*)(lds + 71680);
    LAS float* decs = (LAS float*)(lds + 89088);
    for (int item = wg; item < 256; item += nwg) {
        const int vs = item & 7, h = (item >> 3) & 3, b = item >> 5;
        f32x4 S[4];
#pragma unroll
        for (int te = 0; te < 4; ++te) S[te] = (f32x4){0.f, 0.f, 0.f, 0.f};
        for (int i = tid; i < 64 * 136 / 2; i += 512) ((LAS unsigned*)St)[i] = 0u;
        __syncthreads();
        for (int n = 0; n < 32; ++n) {
            const int chunk = (b * 4 + h) * 32 + n; const size_t m0 = (size_t)b * SEQ + n * 64;
#pragma unroll
            for (int i = 0; i < 2; ++i) {
                const int p = tid + i * 512, row = p >> 4, c8 = p & 15;
                const bf16_t* src = QK + (m0 + row) * 1280 + h * 128 + c8 * 8;
                *(LAS u32x4*)(Qs + row * 136 + c8 * 8) = *(const u32x4*)src;
                *(LAS u32x4*)(Ks + row * 136 + c8 * 8) = *(const u32x4*)(src + 512);
                const int row2 = p >> 3, c82 = p & 7;
                *(LAS u32x4*)(KEs + row2 * 72 + c82 * 8) = *(const u32x4*)(KENDT + ((size_t)chunk * 128 + row2) * 64 + c82 * 8);
            }
            {
                const int s = tid >> 3, c8 = tid & 7;
                const u32x4 vv = *(const u32x4*)(PA + (m0 + s) * 4096 + h * 512 + vs * 64 + c8 * 8);
                const unsigned vw[4] = {vv.x, vv.y, vv.z, vv.w};
#pragma unroll
                for (int k = 0; k < 4; ++k) { Vt[(c8 * 8 + 2 * k) * 72 + s] = (bf16_t)(vw[k] & 0xffffu); Vt[(c8 * 8 + 2 * k + 1) * 72 + s] = (bf16_t)(vw[k] >> 16); }
            }
            if (tid < 128) decs[tid] = DEC[chunk * 128 + tid];
            __syncthreads();
#pragma unroll
            for (int q = 0; q < 2; ++q) {
                const int t = wave * 2 + q, tc = t >> 2, ts = t & 3;
                f32x4 a4 = (f32x4){0.f, 0.f, 0.f, 0.f};
#pragma unroll
                for (int kk = 0; kk < 4; ++kk) {
                    const bf16x8 ka = *(const LAS bf16x8*)(Ks + (ts * 16 + fr) * 136 + kk * 32 + fq * 8);
                    const bf16x8 qb = *(const LAS bf16x8*)(Qs + (tc * 16 + fr) * 136 + kk * 32 + fq * 8);
                    a4 = __builtin_amdgcn_mfma_f32_16x16x32_bf16(ka, qb, a4, 0, 0, 0);
                }
                const int c = tc * 16 + fr, s0 = ts * 16 + fq * 4;
                float v[4];
#pragma unroll
                for (int j = 0; j < 4; ++j) v[j] = (s0 + j <= c) ? a4[j] : 0.f;
                u32x2 w; w.x = cvt_pk_bf16(v[0], v[1]); w.y = cvt_pk_bf16(v[2], v[3]);
                *(LAS u32x2*)(As + c * 72 + s0) = w;
            }
            __syncthreads();
            {
                const int tc = wave >> 1; float ss = 0.f;
#pragma unroll
                for (int q = 0; q < 2; ++q) {
                    const int te = (wave & 1) * 2 + q;
                    f32x4 o4 = (f32x4){0.f, 0.f, 0.f, 0.f};
#pragma unroll
                    for (int kk = 0; kk < 2; ++kk) {
                        const bf16x8 va = *(const LAS bf16x8*)(Vt + (te * 16 + fr) * 72 + kk * 32 + fq * 8);
                        const bf16x8 ab = *(const LAS bf16x8*)(As + (tc * 16 + fr) * 72 + kk * 32 + fq * 8);
                        o4 = __builtin_amdgcn_mfma_f32_16x16x32_bf16(va, ab, o4, 0, 0, 0);
                    }
#pragma unroll
                    for (int kk = 0; kk < 4; ++kk) {
                        const bf16x8 sa = *(const LAS bf16x8*)(St + (te * 16 + fr) * 136 + kk * 32 + fq * 8);
                        const bf16x8 qb = *(const LAS bf16x8*)(Qs + (tc * 16 + fr) * 136 + kk * 32 + fq * 8);
                        o4 = __builtin_amdgcn_mfma_f32_16x16x32_bf16(sa, qb, o4, 0, 0, 0);
                    }
                    ss += (o4[0] * o4[0] + o4[1] * o4[1]) + (o4[2] * o4[2] + o4[3] * o4[3]);
                    u32x2 w; w.x = cvt_pk_bf16(o4[0], o4[1]); w.y = cvt_pk_bf16(o4[2], o4[3]);
                    *(u32x2*)(PA + (m0 + tc * 16 + fr) * 4096 + h * 512 + vs * 64 + te * 16 + fq * 4) = w;
                }
                ss += __shfl_xor(ss, 16); ss += __shfl_xor(ss, 32);
                if (fq == 0) SSQ[((m0 + tc * 16 + fr) * 4 + h) * 16 + vs * 2 + (wave & 1)] = ss;
            }
            {
                const f32x4 dv = *(const LAS f32x4*)(decs + wave * 16 + fq * 4);
#pragma unroll
                for (int te = 0; te < 4; ++te) {
                    S[te] = S[te] * dv;
#pragma unroll
                    for (int kk = 0; kk < 2; ++kk) {
                        const bf16x8 ka = *(const LAS bf16x8*)(KEs + (wave * 16 + fr) * 72 + kk * 32 + fq * 8);
                        const bf16x8 vb = *(const LAS bf16x8*)(Vt + (te * 16 + fr) * 72 + kk * 32 + fq * 8);
                        S[te] = __builtin_amdgcn_mfma_f32_16x16x32_bf16(ka, vb, S[te], 0, 0, 0);
                    }
                }
            }
            __syncthreads();
#pragma unroll
            for (int te = 0; te < 4; ++te) {
                u32x2 w; w.x = cvt_pk_bf16(S[te][0], S[te][1]); w.y = cvt_pk_bf16(S[te][2], S[te][3]);
                *(LAS u32x2*)(St + (te * 16 + fr) * 136 + wave * 16 + fq * 4) = w;
            }
        }
        __syncthreads();
    }
}

__device__ __attribute__((noinline)) void gla_gate(bf16_t* PA, const float* SSQ, const float* gain  , int wg, int nwg) {
    const size_t total = (size_t)MTOK * 256;
    for (size_t p = (size_t)wg * 512 + threadIdx.x; p < total; p += (size_t)nwg * 512) {
        const size_t m = p >> 8; const int col = (int)(p & 255) * 8, h = col >> 9, e = col & 511;
        const f32x4* sp = (const f32x4*)(SSQ + (m * 4 + h) * 16);
        const f32x4 s = (sp[0] + sp[1]) + (sp[2] + sp[3]);
        const float rs = rsqrtf(((s[0] + s[1]) + (s[2] + s[3])) * (1.0f / 512.0f) + EPS);
        bf16_t* op = PA + m * 4096 + col;
        const u32x4 ov = *(const u32x4*)op, zv = *(const u32x4*)(op + 2048);
        const f32x4 g0 = *(const f32x4*)(gain + e), g1 = *(const f32x4*)(gain + e + 4);
        const unsigned ow[4] = {ov.x, ov.y, ov.z, ov.w}, zw[4] = {zv.x, zv.y, zv.z, zv.w};
        const float gg[8] = {g0[0], g0[1], g0[2], g0[3], g1[0], g1[1], g1[2], g1[3]};
        unsigned r[4];
#pragma unroll
        for (int k = 0; k < 4; ++k) {
            const float oa = bflo(ow[k]), ob = bfhi(ow[k]), za = bflo(zw[k]), zb = bfhi(zw[k]);
            r[k] = cvt_pk_bf16(oa * rs * gg[2 * k] * (za * sigmoidf_(za)), ob * rs * gg[2 * k + 1] * (zb * sigmoidf_(zb)));
        }
        *(u32x4*)op = (u32x4){r[0], r[1], r[2], r[3]};
    }
}

__device__ __forceinline__ float gelu_tanh(float y) { return 0.5f * y * (1.0f + tanhf(0.7978845608028654f * (y + 0.044715f * y * y * y))); }
__device__ __attribute__((noinline)) void s5_simple(LAS unsigned char* lds, bf16_t* PA, const float* lam_re, const float* lam_im, const float* log_dt, const float* b_re, const float* b_im,
                                          const float* c_re, const float* c_im, const float* dsk, int wg, int nwg) {
    const int wave = threadIdx.x >> 6, lane = threadIdx.x & 63;
    if (wave < 4) {
        LAS float* cS = (LAS float*)lds + wave * 4416;
        LAS float* sS = cS + 2080;
        LAS float* uS = sS + 2080;
        for (int item = wg * 4 + wave; item < 1024; item += nwg * 4) {
            const int g = item & 127, b = item >> 7, p = lane;
            const float lr = lam_re[g * 64 + p], li = lam_im[g * 64 + p], dt = expf(log_dt[g]);
            const float mag = expf(lr * dt), ang = li * dt, lbr = mag * cosf(ang), lbi = mag * sinf(ang);
            const float nr = lbr - 1.0f, ni = lbi, den = lr * lr + li * li;
            const float bcr = (nr * lr + ni * li) / den, bci = (ni * lr - nr * li) / den;
            float Br[16], Bi[16];
#pragma unroll
            for (int j = 0; j < 16; ++j) { const float xr = b_re[(size_t)(g * 64 + p) * 16 + j], xi = b_im[(size_t)(g * 64 + p) * 16 + j]; Br[j] = bcr * xr - bci * xi; Bi[j] = bcr * xi + bci * xr; }
            __builtin_amdgcn_wave_barrier();
#pragma unroll
            for (int i = 0; i < 16; ++i) { cS[i * 65 + p] = c_re[(size_t)(g * 16 + i) * 64 + p]; cS[1040 + i * 65 + p] = c_im[(size_t)(g * 16 + i) * 64 + p]; }
            const int tt = lane >> 2, i0 = (lane & 3) * 4;
            float dk[4];
#pragma unroll
            for (int k = 0; k < 4; ++k) dk[k] = dsk[g * 16 + i0 + k];
            float sr = 0.f, si = 0.f;
            for (int t0 = 0; t0 < SEQ; t0 += 16) {
                const size_t m0 = (size_t)b * SEQ + t0;
                bf16_t* up = PA + (m0 + tt) * 4096 + g * 16 + i0;
                const u32x2 uv = *(const u32x2*)up;
                uS[tt * 16 + i0 + 0] = bflo(uv.x); uS[tt * 16 + i0 + 1] = bfhi(uv.x); uS[tt * 16 + i0 + 2] = bflo(uv.y); uS[tt * 16 + i0 + 3] = bfhi(uv.y);
                __builtin_amdgcn_fence(__ATOMIC_RELEASE, "wavefront"); __builtin_amdgcn_wave_barrier(); __builtin_amdgcn_fence(__ATOMIC_ACQUIRE, "wavefront");
#pragma unroll 4
                for (int t = 0; t < 16; ++t) {
                    float bur = 0.f, bui = 0.f;
#pragma unroll
                    for (int j = 0; j < 16; ++j) { const float uu = uS[t * 16 + j]; bur += Br[j] * uu; bui += Bi[j] * uu; }
                    const float nsr = lbr * sr - lbi * si + bur, nsi = lbr * si + lbi * sr + bui;
                    sr = nsr; si = nsi;
                    sS[t * 130 + 2 * p] = sr; sS[t * 130 + 2 * p + 1] = si;
                }
                __builtin_amdgcn_fence(__ATOMIC_RELEASE, "wavefront"); __builtin_amdgcn_wave_barrier(); __builtin_amdgcn_fence(__ATOMIC_ACQUIRE, "wavefront");
                float y[4] = {0.f, 0.f, 0.f, 0.f};
                for (int pp = 0; pp < 64; ++pp) {
                    const float re = sS[tt * 130 + 2 * pp], im = sS[tt * 130 + 2 * pp + 1];
#pragma unroll
                    for (int k = 0; k < 4; ++k) y[k] += re * cS[(i0 + k) * 65 + pp] - im * cS[1040 + (i0 + k) * 65 + pp];
                }
                float o[4];
#pragma unroll
                for (int k = 0; k < 4; ++k) o[k] = gelu_tanh(y[k] + dk[k] * uS[tt * 16 + i0 + k]);
                u32x2 w; w.x = cvt_pk_bf16(o[0], o[1]); w.y = cvt_pk_bf16(o[2], o[3]);
                *(u32x2*)up = w;
                __builtin_amdgcn_fence(__ATOMIC_RELEASE, "wavefront"); __builtin_amdgcn_wave_barrier(); __builtin_amdgcn_fence(__ATOMIC_ACQUIRE, "wavefront");
            }
        }
    }
}

struct Params { const float* in[21]; float* out; unsigned char* ws; };

__global__ void __launch_bounds__(512, 2) fwd_megakernel(Params P) {
    extern __shared__ __attribute__((aligned(16))) unsigned char lds_raw[];
    LAS unsigned char* lds = (LAS unsigned char*)lds_raw;
    cg::grid_group grid = cg::this_grid();
    const int wg = blockIdx.x, nwg = gridDim.x;
    unsigned char* ws = P.ws;
    bf16_t* WGLA_IN = (bf16_t*)(ws + WS_WGLA_IN); bf16_t* WGLA_OUT = (bf16_t*)(ws + WS_WGLA_OUT);
    bf16_t* WS5_IN = (bf16_t*)(ws + WS_WS5_IN); bf16_t* WS5_GLU = (bf16_t*)(ws + WS_WS5_GLU); bf16_t* WS5_OUT = (bf16_t*)(ws + WS_WS5_OUT);
    bf16_t* XB = (bf16_t*)(ws + WS_XB); bf16_t* KENDT = XB;
    bf16_t* PA = (bf16_t*)(ws + WS_PA); bf16_t* QK = (bf16_t*)(ws + WS_QK);
    float* RSS = (float*)(ws + WS_RSS); float* DEC = (float*)(ws + WS_DEC); float* SSQ = (float*)(ws + WS_SSQ);
    const float* x = P.in[0];
    float* out = P.out;

    convert_wt(lds, P.in[2], P.in[1], WGLA_IN, 1024, GLA_IN, GLA_NP, wg, nwg);
    convert_wt(lds, P.in[6], nullptr, WGLA_OUT, 2048, 1024, 1024, wg, nwg);
    convert_wt(lds, P.in[8], P.in[7], WS5_IN, 1024, 4096, 4096, wg, nwg);
    convert_wt(lds, P.in[17], nullptr, WS5_GLU, 2048, 2048, 2048, wg, nwg);
    convert_wt(lds, P.in[19], nullptr, WS5_OUT, 2048, 1024, 1024, wg, nwg);
    xprep(x, XB, RSS, wg, nwg);
    grid.sync();

    for (int layer = 0; layer < 4; ++layer) {
        const int j = layer >> 1;
        const bool is_s5 = (layer & 1) != 0;
        const float* resid = (layer == 0) ? x : out;
        { pg8::Gemm g{XB, is_s5 ? WS5_IN : WGLA_IN, MTOK, is_s5 ? 4096 : GLA_NP, 1024, 1024}; pg8::StaticOrder S; S.init(MTOK, g.N, nwg, wg);
          EpiProj E{PA, QK, RSS, is_s5 ? 0 : 4, is_s5 ? 16 : 20}; pg8::gemm_phase<EpiProj>(lds, g, S, E); }
        grid.sync();
        if (!is_s5) {
            if (layer == 2) {
                convert_wt(lds, P.in[8] + (size_t)1024 * 4096, P.in[7] + 1024, WS5_IN, 1024, 4096, 4096, wg, nwg);
                convert_wt(lds, P.in[17] + (size_t)2048 * 2048, nullptr, WS5_GLU, 2048, 2048, 2048, wg, nwg);
                convert_wt(lds, P.in[19] + (size_t)2048 * 1024, nullptr, WS5_OUT, 2048, 1024, 1024, wg, nwg);
            }
            gla_prep(lds, QK, KENDT, DEC, P.in[3] + (size_t)j * 16 * 512, P.in[4] + (size_t)j * 512, wg, nwg);
            grid.sync();
            gla_scan(lds, PA, QK, KENDT, DEC, SSQ, wg, nwg);
            grid.sync();
            gla_gate(PA, SSQ, P.in[5] + (size_t)j * 512, wg, nwg);
            grid.sync();
        } else {
            if (layer == 1) {
                convert_wt(lds, P.in[2] + (size_t)1024 * GLA_IN, P.in[1] + 1024, WGLA_IN, 1024, GLA_IN, GLA_NP, wg, nwg);
                convert_wt(lds, P.in[6] + (size_t)2048 * 1024, nullptr, WGLA_OUT, 2048, 1024, 1024, wg, nwg);
            }
            s5_simple(lds, PA, P.in[9] + (size_t)j * 128 * 64, P.in[10] + (size_t)j * 128 * 64, P.in[11] + (size_t)j * 128,
                      P.in[12] + (size_t)j * 128 * 64 * 16, P.in[13] + (size_t)j * 128 * 64 * 16,
                      P.in[14] + (size_t)j * 128 * 16 * 64, P.in[15] + (size_t)j * 128 * 16 * 64, P.in[16] + (size_t)j * 128 * 16, wg, nwg);
            grid.sync();
            { pg8::Gemm g{PA, WS5_GLU, MTOK, 2048, 2048, 4096}; pg8::StaticOrder S; S.init(MTOK, 2048, nwg, wg);
              EpiGlu E{PA, P.in[18] + (size_t)j * 2048}; pg8::gemm_phase<EpiGlu>(lds, g, S, E); }
            grid.sync();
        }
        { pg8::Gemm g{is_s5 ? PA + 2048 : PA, is_s5 ? WS5_OUT : WGLA_OUT, MTOK, 1024, 2048, 4096}; pg8::StaticOrder S; S.init(MTOK, 1024, nwg, wg);
          EpiOut E{resid, out, XB, RSS}; pg8::gemm_phase<EpiOut>(lds, g, S, E); }
        grid.sync();
    }
    final_norm(out, RSS, P.in[20], wg, nwg);
}

extern "C" void kernel_launch(void* const* d_in, const int* in_sizes, int n_in, void* d_out, int out_size, void* d_ws, size_t ws_size, hipStream_t stream) {
    static int grid_blocks = 0;
    if (!grid_blocks) {
        int dev = 0, cus = 0, per_cu = 0;
        (void)hipGetDevice(&dev);
        (void)hipDeviceGetAttribute(&cus, hipDeviceAttributeMultiprocessorCount, dev);
        (void)hipFuncSetAttribute((const void*)fwd_megakernel, hipFuncAttributeMaxDynamicSharedMemorySize, LDS_BYTES);
        (void)hipOccupancyMaxActiveBlocksPerMultiprocessor(&per_cu, (const void*)fwd_megakernel, 512, LDS_BYTES);
        if (per_cu < 1) { fprintf(stderr, "occupancy query returned %d\n", per_cu); per_cu = 1; }
        if (per_cu > 1) per_cu = 1;
        grid_blocks = cus * per_cu;
        if (ws_size < WS_END) fprintf(stderr, "workspace too small: %zu < %zu\n", ws_size, (size_t)WS_END);
    }
    Params p{};
    for (int i = 0; i < 21; ++i) p.in[i] = (const float*)d_in[i];
    p.out = (float*)d_out; p.ws = (unsigned char*)d_ws;
    void* args[] = {&p};
    hipError_t e = hipLaunchCooperativeKernel((void*)fwd_megakernel, dim3(grid_blocks), dim3(512), args, LDS_BYTES, stream);
    if (e != hipSuccess) fprintf(stderr, "cooperative launch failed: %s (grid %d)\n", hipGetErrorString(e), grid_blocks);
}
```

```cpp
#include <hip/hip_runtime.h>
#include <hip/hip_cooperative_groups.h>
#include <cstdio>
namespace cg = cooperative_groups;

#define LAS __attribute__((address_space(3)))
typedef unsigned short bf16_t;
typedef short bf16x8 __attribute__((ext_vector_type(8)));
typedef float f32x4 __attribute__((ext_vector_type(4)));
typedef float f32x2 __attribute__((ext_vector_type(2)));
typedef unsigned u32x4 __attribute__((ext_vector_type(4)));
typedef unsigned u32x2 __attribute__((ext_vector_type(2)));

constexpr int MTOK = 16384, DM = 1024, DI = 2048, SEQ = 2048;
constexpr int GLA_IN = 5136, GLA_NP = 5376;
constexpr float EPS = 1e-6f;
constexpr int LDS_BYTES = 131072 + 16;

constexpr size_t WS_WGLA_IN = 0;
constexpr size_t WS_WGLA_OUT = WS_WGLA_IN + (size_t)GLA_NP * 1024 * 2;
constexpr size_t WS_WS5_IN = WS_WGLA_OUT + (size_t)1024 * 2048 * 2;
constexpr size_t WS_WS5_GLU = WS_WS5_IN + (size_t)4096 * 1024 * 2;
constexpr size_t WS_WS5_OUT = WS_WS5_GLU + (size_t)2048 * 2048 * 2;
constexpr size_t WS_XB = WS_WS5_OUT + (size_t)1024 * 2048 * 2;
constexpr size_t WS_PA = WS_XB + (size_t)MTOK * 1024 * 2;
constexpr size_t WS_QK = WS_PA + (size_t)MTOK * 4096 * 2;
constexpr size_t WS_RSS = WS_QK + (size_t)MTOK * 1280 * 2;
constexpr size_t WS_DEC = WS_RSS + (size_t)MTOK * 16 * 4;
constexpr size_t WS_SSQ = WS_DEC + (size_t)1024 * 128 * 4;
constexpr size_t WS_BAR = WS_SSQ + (size_t)MTOK * 64 * 4;
constexpr size_t WS_END = WS_BAR + 16384;
constexpr size_t WS_BTY = WS_QK;
constexpr size_t WS_BTF = WS_BTY + (size_t)128 * 256 * 384 * 2;
static_assert(WS_BTF + (size_t)128 * 128 * 256 * 2 <= WS_RSS, "S5 tables must fit in the QK region");
static_assert(WS_END <= (size_t)256 * 1024 * 1024, "workspace budget");

__device__ __forceinline__ float bf2f(bf16_t b) { return __uint_as_float(((unsigned)b) << 16); }
__device__ __forceinline__ float bflo(unsigned w) { return __uint_as_float(w << 16); }
__device__ __forceinline__ float bfhi(unsigned w) { return __uint_as_float(w & 0xffff0000u); }
__device__ __forceinline__ unsigned cvt_pk_bf16(float lo, float hi) { unsigned r; asm volatile("v_cvt_pk_bf16_f32 %0, %1, %2" : "=v"(r) : "v"(lo), "v"(hi)); return r; }
__device__ __forceinline__ bf16_t f2bf(float f) { return (bf16_t)(cvt_pk_bf16(f, 0.f) & 0xffffu); }
__device__ __forceinline__ float sigmoidf_(float x) { return 1.0f / (1.0f + __expf(-x)); }
__device__ __forceinline__ float wave_sum(float v) {
#pragma unroll
    for (int o = 32; o > 0; o >>= 1) v += __shfl_xor(v, o);
    return v;
}


#define XB_TMO      128
#define XB_XCNT(j)  (256  + 64 * (j))
#define XB_XSUB(j)  (1280 + 64 * (j))
#define XB_XGEN(j)  (2304 + 64 * (j))
#define XB_TOP      3328
#define XB_TOPGEN   3392
#define XCD_BAR_WORDS 3456
#define XB_SPIN_CAP (1u << 18)
__device__ __forceinline__ unsigned xb_ld(unsigned* p)              { return __hip_atomic_load(p, __ATOMIC_RELAXED, __HIP_MEMORY_SCOPE_AGENT); }
__device__ __forceinline__ unsigned xb_add(unsigned* p, unsigned v) { return __hip_atomic_fetch_add(p, v, __ATOMIC_RELAXED, __HIP_MEMORY_SCOPE_AGENT); }
__device__ __forceinline__ unsigned xb_xcc_id() { return (unsigned)__builtin_amdgcn_s_getreg((3 << 11) | 20) & 0xFu; }
#define XB_SPIN(cond, bar) do { unsigned _sp = 0; while (cond) { __builtin_amdgcn_s_sleep(1); \
    if ((++_sp & 255u) == 0u) { if (xb_ld(&(bar)[XB_TMO])) break; if (_sp > XB_SPIN_CAP) { atomicAdd(&(bar)[XB_TMO], 1u); break; } } } } while (0)
struct XcdBarrier { unsigned* bar; unsigned x; volatile LAS unsigned* st; };
__device__ __forceinline__ XcdBarrier xcd_barrier_post(unsigned* bar, volatile LAS unsigned* st) {
    XcdBarrier b; b.bar = bar; b.x = xb_xcc_id(); b.st = st;
    if (threadIdx.x == 0) (void)xb_add(&bar[XB_XCNT(b.x)], 1u);
    return b;
}
__device__ __forceinline__ void xcd_barrier_complete(unsigned* bar, unsigned x, unsigned& nloc, unsigned& nx) {
    const unsigned G = gridDim.x * gridDim.y * gridDim.z;
    unsigned sum, cnt, mine, sp = 0u;
    for (;;) {
        sum = 0u; cnt = 0u; mine = 0u;
#pragma unroll
        for (unsigned j = 0; j < 16; ++j) { const unsigned c = xb_ld(&bar[XB_XCNT(j)]); sum += c; cnt += (c > 0u) ? 1u : 0u; mine = (j == x) ? c : mine; }
        if (sum == G) break;
        __builtin_amdgcn_s_sleep(1);
        if ((++sp & 255u) == 0u) { if (xb_ld(&bar[XB_TMO])) break; if (sp > XB_SPIN_CAP) { atomicAdd(&bar[XB_TMO], 1u); break; } }
    }
    nloc = mine > 0u ? mine : 1u; nx = cnt > 0u ? cnt : 1u;
}
__device__ __attribute__((noinline)) void xcd_barrier(unsigned* bar, unsigned x, volatile LAS unsigned* st) {
    asm volatile("s_waitcnt vmcnt(0)" ::: "memory");
    __syncthreads();
    if (threadIdx.x == 0) {
        __builtin_amdgcn_s_waitcnt(0);
        unsigned nloc = st[0], nx = st[1];
        if (nloc == 0u) { xcd_barrier_complete(bar, x, nloc, nx); st[0] = nloc; st[1] = nx; }
        const unsigned old = xb_add(&bar[XB_XSUB(x)], 1u);
        const unsigned gen = old / nloc;
        if (old + 1u == (gen + 1u) * nloc) {
            __builtin_amdgcn_fence(__ATOMIC_RELEASE, "agent");
            asm volatile("s_waitcnt vmcnt(0)" ::: "memory");
            const unsigned og = xb_add(&bar[XB_TOP], 1u);
            const unsigned tg = og / nx;
            if (og + 1u == (tg + 1u) * nx) xb_add(&bar[XB_TOPGEN], 1u);
            else XB_SPIN(xb_ld(&bar[XB_TOPGEN]) == tg, bar);
            __builtin_amdgcn_fence(__ATOMIC_ACQUIRE, "agent");
            xb_add(&bar[XB_XGEN(x)], 1u);
            asm volatile("s_waitcnt vmcnt(0)" ::: "memory");
        } else {
            XB_SPIN(xb_ld(&bar[XB_XGEN(x)]) == gen, bar);
            __builtin_amdgcn_fence(__ATOMIC_ACQUIRE, "agent");
            asm volatile("s_waitcnt vmcnt(0)" ::: "memory");
        }
    }
    __syncthreads();
}

namespace pg8 {
constexpr int BM = 256, BK = 64, HALF = 128, HTB = HALF * BK * 2, STAGE_BYTES = 8 * HTB, NXCD = 8, WGM = 8;
__host__ __device__ __forceinline__ int lds_byte(int r, int c) { const int st = (r >> 4) * 2 + (c >> 5), rr = r & 15, cc = c & 31, ob = rr * 64 + cc * 2; return st * 1024 + (ob ^ (((ob >> 9) & 1) << 5)); }
__host__ __device__ __forceinline__ void stage_rc(int b, int& R, int& C) { const int st = b / 1024, sb = b % 1024, swz = sb ^ (((sb >> 9) & 1) << 5); R = (st >> 1) * 16 + swz / 64; C = (st & 1) * 32 + (swz % 64) / 2; }
__host__ __device__ __forceinline__ int perm32(int rho) { const int n = rho >> 4, i = rho & 15; return 8 * (i >> 2) + 4 * n + (i & 3); }

struct Unit { int pm, pn; };
struct Gemm { const bf16_t* A; const bf16_t* Bt; int M, N, K, lda; };

struct StaticOrder {
    int nM, nN, nwg, G, c;
    __host__ __device__ void init(int M, int N, int G_, int c_) { nM = M / BM; nN = N / BM; nwg = nM * nN; G = G_; c = c_; }
    __host__ __device__ bool next(int i, Unit& u) const {
        const long L = (long)i * G + c; if (L >= nwg) return false;
        int wgid = (int)L; { const int q = nwg / NXCD, r = nwg % NXCD, xcd = wgid % NXCD, off = wgid / NXCD; wgid = (xcd < r ? xcd * (q + 1) : r * (q + 1) + (xcd - r) * q) + off; }
        const int nig = WGM * nN, gid = wgid / nig, fm = gid * WGM, gsz = (nM - fm) < WGM ? (nM - fm) : WGM;
        u.pm = fm + ((wgid % nig) % gsz); u.pn = (wgid % nig) / gsz; return true;
    }
};

template <class Epi>
__device__ __forceinline__ void gemm_phase(LAS unsigned char* lds, const Gemm g, const StaticOrder& S, const Epi& E) {
    int tid_ = threadIdx.x; asm volatile("" : "+v"(tid_));
    const int tid = tid_, wid = __builtin_amdgcn_readfirstlane(tid >> 6), lane = tid & 63, wr = wid >> 2, wc = wid & 3, fr = lane & 15, fq = lane >> 4;
    const int K = g.K, nt = K / BK, lda = g.lda;
    unsigned voffA[2], voffB[2];
#pragma unroll
    for (int i = 0; i < 2; ++i) { int R, C; stage_rc(tid * 16 + i * 8192, R, C); const int Rb = Epi::PERM ? ((R & ~31) + perm32(R & 31)) : R;
        voffA[i] = (unsigned)(R * lda + C) * 2u; voffB[i] = (unsigned)(Rb * K + C) * 2u; }
    const size_t kstep = (size_t)(BK * 2);
    const size_t hstepA = (size_t)HALF * lda * 2, hstepB = (size_t)HALF * K * 2;
    const size_t tstepA = 2 * hstepA, tstepB = 2 * hstepB;
    const unsigned ldsw = (unsigned)wid * 1024u;
    const int aoff = lds_byte(wr * 64 + fr, fq * 8), boff = lds_byte(wc * 32 + fr, fq * 8);
#define PG8_SA(b, h) (((b) * 2 + (h)) * HTB)
#define PG8_SB(b, h) ((4 + (b) * 2 + (h)) * HTB)
#define PG8_STAGE(bufoff, gbase, voff) do { _Pragma("unroll") for (int _i = 0; _i < 2; ++_i) \
        __builtin_amdgcn_global_load_lds((const unsigned*)((const char*)(gbase) + (voff)[_i]), (LAS unsigned*)(lds + (bufoff) + ldsw + _i * 8192), 16, 0, 0); } while (0)
#define PG8_LDA(dst, b, h) do { _Pragma("unroll") for (int m = 0; m < 4; ++m) _Pragma("unroll") for (int k = 0; k < 2; ++k) dst[m][k] = *(const LAS bf16x8*)(lds + PG8_SA(b, h) + aoff + m * 2048 + k * 1024); } while (0)
#define PG8_LDB(dst, b, h) do { _Pragma("unroll") for (int n = 0; n < 2; ++n) _Pragma("unroll") for (int k = 0; k < 2; ++k) dst[n][k] = *(const LAS bf16x8*)(lds + PG8_SB(b, h) + boff + n * 2048 + k * 1024); } while (0)
#define PG8_MMA(ai, bj, At, Bt) do { __builtin_amdgcn_s_setprio(1); _Pragma("unroll") for (int m = 0; m < 4; ++m) _Pragma("unroll") for (int n = 0; n < 2; ++n) _Pragma("unroll") for (int k = 0; k < 2; ++k) \
        acc[ai][bj][m][n] = __builtin_amdgcn_mfma_f32_16x16x32_bf16(Bt[n][k], At[m][k], acc[ai][bj][m][n], 0, 0, 0); __builtin_amdgcn_s_setprio(0); } while (0)
#define PG8_WAIT_V(n) asm volatile("s_waitcnt vmcnt(" #n ")" ::: "memory")
#define PG8_WAIT_L(n) asm volatile("s_waitcnt lgkmcnt(" #n ")" ::: "memory")
#define PG8_BAR __builtin_amdgcn_s_barrier()
#define PG8_SCHED __builtin_amdgcn_sched_barrier(0)
    Unit cur, nxt; int ui = 0;
    if (!S.next(0, cur)) return;
    f32x4 acc[2][2][4][2];
#pragma unroll
    for (int a = 0; a < 2; ++a)
#pragma unroll
        for (int b = 0; b < 2; ++b)
#pragma unroll
            for (int m = 0; m < 4; ++m)
#pragma unroll
                for (int n = 0; n < 2; ++n) acc[a][b][m][n] = (f32x4){0.f, 0.f, 0.f, 0.f};
    bf16x8 At[4][2], B0[2][2], B1[2][2];
    const char* cA = (const char*)g.A + (size_t)cur.pm * tstepA; const char* cB = (const char*)g.Bt + (size_t)cur.pn * tstepB;
    PG8_STAGE(PG8_SB(0, 0), cB, voffB); PG8_STAGE(PG8_SA(0, 0), cA, voffA); PG8_STAGE(PG8_SB(0, 1), cB + hstepB, voffB); PG8_STAGE(PG8_SA(0, 1), cA + hstepA, voffA);
    if (wr == 1) PG8_BAR;
    PG8_WAIT_V(4); PG8_BAR;
    PG8_STAGE(PG8_SB(1, 0), cB + kstep, voffB); PG8_STAGE(PG8_SA(1, 0), cA + kstep, voffA); PG8_STAGE(PG8_SB(1, 1), cB + hstepB + kstep, voffB);
    PG8_WAIT_V(6); PG8_BAR;
    for (;;) {
        const bool has_next = S.next(ui + 1, nxt);
        const char* nA = has_next ? (const char*)g.A + (size_t)nxt.pm * tstepA : cA; const char* nB = has_next ? (const char*)g.Bt + (size_t)nxt.pn * tstepB : cB;
        for (int t = 0; t < nt; t += 2) {
            const bool last = (t == nt - 2);
            const char* a1 = cA + (size_t)(t + 1) * kstep;
            const char* a2 = last ? nA : cA + (size_t)(t + 2) * kstep; const char* b2 = last ? nB : cB + (size_t)(t + 2) * kstep;
            const char* a3 = a2 + kstep; const char* b3 = b2 + kstep;
            PG8_LDB(B0, 0, 0); PG8_SCHED; PG8_LDA(At, 0, 0); PG8_STAGE(PG8_SA(1, 1), a1 + hstepA, voffA);
            PG8_WAIT_L(8); PG8_BAR; PG8_WAIT_L(0); PG8_MMA(0, 0, At, B0); PG8_BAR; PG8_SCHED;
            PG8_LDB(B1, 0, 1); PG8_STAGE(PG8_SB(0, 0), b2, voffB);
            PG8_BAR; PG8_WAIT_L(0); PG8_MMA(0, 1, At, B1); PG8_BAR;
            PG8_LDA(At, 0, 1); PG8_STAGE(PG8_SA(0, 0), a2, voffA);
            PG8_BAR; PG8_WAIT_L(0); PG8_MMA(1, 0, At, B0); PG8_BAR; PG8_SCHED;
            PG8_STAGE(PG8_SB(0, 1), b2 + hstepB, voffB);
            PG8_WAIT_V(6); PG8_BAR; PG8_MMA(1, 1, At, B1); PG8_BAR;
            PG8_LDB(B0, 1, 0); PG8_SCHED; PG8_LDA(At, 1, 0); PG8_STAGE(PG8_SA(0, 1), a2 + hstepA, voffA);
            PG8_WAIT_L(8); PG8_BAR; PG8_WAIT_L(0); PG8_MMA(0, 0, At, B0); PG8_BAR; PG8_SCHED;
            PG8_LDB(B1, 1, 1); PG8_STAGE(PG8_SB(1, 0), b3, voffB);
            PG8_BAR; PG8_WAIT_L(0); PG8_MMA(0, 1, At, B1); PG8_BAR;
            PG8_LDA(At, 1, 1); PG8_STAGE(PG8_SA(1, 0), a3, voffA);
            PG8_BAR; PG8_WAIT_L(0); PG8_MMA(1, 0, At, B0); PG8_BAR; PG8_SCHED;
            PG8_STAGE(PG8_SB(1, 1), b3 + hstepB, voffB);
            PG8_WAIT_V(6); PG8_BAR; PG8_MMA(1, 1, At, B1); PG8_BAR;
        }
        E(acc, cur, wr, wc, fr, fq);
        if (!has_next) break;
#pragma unroll
        for (int a = 0; a < 2; ++a)
#pragma unroll
            for (int b = 0; b < 2; ++b)
#pragma unroll
                for (int m = 0; m < 4; ++m)
#pragma unroll
                    for (int n = 0; n < 2; ++n) acc[a][b][m][n] = (f32x4){0.f, 0.f, 0.f, 0.f};
        cur = nxt; cA = nA; cB = nB; ++ui;
    }
    PG8_WAIT_V(0);
    if (wr == 0) PG8_BAR;
    PG8_BAR;
#undef PG8_SA
#undef PG8_SB
#undef PG8_STAGE
#undef PG8_LDA
#undef PG8_LDB
#undef PG8_MMA
#undef PG8_WAIT_V
#undef PG8_WAIT_L
#undef PG8_BAR
#undef PG8_SCHED
}
}

__device__ __forceinline__ float row_rs(const float* rowss, int r) {
    const f32x4* rp = (const f32x4*)(rowss + (size_t)r * 16);
    const f32x4 s = (rp[0] + rp[1]) + (rp[2] + rp[3]);
    return rsqrtf(((s[0] + s[1]) + (s[2] + s[3])) * (1.0f / 1024.0f) + EPS);
}

struct EpiProj {
    static constexpr bool PERM = true;
    bf16_t* PA; bf16_t* QK; const float* rowss; int lo, hi;
    __device__ __forceinline__ void operator()(const f32x4 (&acc)[2][2][4][2], const pg8::Unit& u, int wr, int wc, int fr, int fq) const {
        bf16_t* base; int ld, colt;
        if (u.pn >= lo && u.pn < hi) { base = PA; ld = 4096; colt = (u.pn - lo) * 256; }
        else { base = QK; ld = 1280; colt = (u.pn < lo ? u.pn : u.pn - (hi - lo)) * 256; }
        const int row0 = u.pm * 256 + wr * 64 + fr, col0 = colt + wc * 32 + 8 * fq;
#pragma unroll
        for (int ai = 0; ai < 2; ++ai)
#pragma unroll
            for (int m = 0; m < 4; ++m) {
                const int r = row0 + ai * 128 + m * 16;
                const float rs = row_rs(rowss, r);
                bf16_t* rowp = base + (size_t)r * ld + col0;
#pragma unroll
                for (int bj = 0; bj < 2; ++bj) {
                    const f32x4 v0 = acc[ai][bj][m][0] * rs, v1 = acc[ai][bj][m][1] * rs;
                    u32x4 w; w.x = cvt_pk_bf16(v0[0], v0[1]); w.y = cvt_pk_bf16(v0[2], v0[3]); w.z = cvt_pk_bf16(v1[0], v1[1]); w.w = cvt_pk_bf16(v1[2], v1[3]);
                    *(u32x4*)(rowp + bj * 128) = w;
                }
            }
    }
};

struct EpiOut {
    static constexpr bool PERM = false;
    const float* base; float* out; bf16_t* xb; float* rowss;
    __device__ __forceinline__ void operator()(const f32x4 (&acc)[2][2][4][2], const pg8::Unit& u, int wr, int wc, int fr, int fq) const {
        const int row0 = u.pm * 256 + wr * 64 + fr, col0 = u.pn * 256 + wc * 32 + 4 * fq;
#pragma unroll
        for (int ai = 0; ai < 2; ++ai)
#pragma unroll
            for (int m = 0; m < 4; ++m) {
                const int r = row0 + ai * 128 + m * 16;
                const size_t off = (size_t)r * 1024 + col0;
                float ss = 0.f;
#pragma unroll
                for (int bj = 0; bj < 2; ++bj)
#pragma unroll
                    for (int n = 0; n < 2; ++n) {
                        const f32x4 b = *(const f32x4*)(base + off + bj * 128 + n * 16);
                        const f32x4 o = b + acc[ai][bj][m][n];
                        *(f32x4*)(out + off + bj * 128 + n * 16) = o;
                        ss += (o[0] * o[0] + o[1] * o[1]) + (o[2] * o[2] + o[3] * o[3]);
                        u32x2 w; w.x = cvt_pk_bf16(o[0], o[1]); w.y = cvt_pk_bf16(o[2], o[3]);
                        *(u32x2*)(xb + off + bj * 128 + n * 16) = w;
                    }
                ss += __shfl_xor(ss, 16); ss += __shfl_xor(ss, 32);
                if (fq == 0) rowss[(size_t)r * 16 + u.pn * 4 + wc] = ss;
            }
    }
};

struct EpiGlu {
    static constexpr bool PERM = true;
    bf16_t* PA; const float* bias;
    __device__ __forceinline__ void operator()(const f32x4 (&acc)[2][2][4][2], const pg8::Unit& u, int wr, int wc, int fr, int fq) const {
        const int row0 = u.pm * 256 + wr * 64 + fr, col0 = u.pn * 256 + wc * 32 + 8 * fq;
        f32x4 bv[2][2];
#pragma unroll
        for (int bj = 0; bj < 2; ++bj)
#pragma unroll
            for (int n = 0; n < 2; ++n) bv[bj][n] = *(const f32x4*)(bias + col0 + bj * 128 + 4 * n);
#pragma unroll
        for (int ai = 0; ai < 2; ++ai)
#pragma unroll
            for (int m = 0; m < 4; ++m) {
                const int r = row0 + ai * 128 + m * 16;
                bf16_t* rowp = PA + (size_t)r * 4096 + col0;
#pragma unroll
                for (int bj = 0; bj < 2; ++bj) {
                    const u32x4 yv = *(const u32x4*)(rowp + bj * 128);
                    const u32x4 zv = *(const u32x4*)(rowp + 2048 + bj * 128);
                    const f32x4 s0 = acc[ai][bj][m][0] + bv[bj][0], s1 = acc[ai][bj][m][1] + bv[bj][1];
                    float o[8];
                    const unsigned yw[4] = {yv.x, yv.y, yv.z, yv.w}, zw[4] = {zv.x, zv.y, zv.z, zv.w};
#pragma unroll
                    for (int k = 0; k < 4; ++k) {
                        const float sa = (k < 2) ? s0[2 * k] : s1[2 * k - 4], sb = (k < 2) ? s0[2 * k + 1] : s1[2 * k - 3];
                        const float ya = bflo(yw[k]), yb = bfhi(yw[k]), za = bflo(zw[k]), zb = bfhi(zw[k]);
                        o[2 * k] = ya * sigmoidf_(sa) * (za * sigmoidf_(za));
                        o[2 * k + 1] = yb * sigmoidf_(sb) * (zb * sigmoidf_(zb));
                    }
                    u32x4 w; w.x = cvt_pk_bf16(o[0], o[1]); w.y = cvt_pk_bf16(o[2], o[3]); w.z = cvt_pk_bf16(o[4], o[5]); w.w = cvt_pk_bf16(o[6], o[7]);
                    *(u32x4*)(rowp + 2048 + bj * 128) = w;
                }
            }
    }
};

__device__ __attribute__((noinline)) void convert_wt(LAS unsigned char* lds, const float* W, const float* gain, bf16_t* Wt, int K, int N, int Npad, int wg, int nwg) {
    LAS float* tile = (LAS float*)lds;
    const int tid = threadIdx.x;
    const int tilesK = K / 64, tilesN = Npad / 64;
    for (int t = wg; t < tilesK * tilesN; t += nwg) {
        const int k0 = (t % tilesK) * 64, n0 = (t / tilesK) * 64;
#pragma unroll
        for (int i = 0; i < 8; ++i) {
            const int idx = tid + i * 512, kk = idx >> 6, nn = idx & 63, n = n0 + nn;
            float v = (n < N) ? W[(size_t)(k0 + kk) * N + n] : 0.f;
            if (gain) v *= gain[k0 + kk];
            tile[nn * 65 + kk] = v;
        }
        __syncthreads();
#pragma unroll
        for (int i = 0; i < 4; ++i) {
            const int p = tid + i * 512, nn = p >> 5, kp = p & 31;
            const float a = tile[nn * 65 + 2 * kp], b = tile[nn * 65 + 2 * kp + 1];
            *(unsigned*)(Wt + (size_t)(n0 + nn) * K + k0 + 2 * kp) = cvt_pk_bf16(a, b);
        }
        __syncthreads();
    }
}

__device__ __attribute__((noinline)) void xprep(const float* x, bf16_t* xb, float* rowss, int wg, int nwg) {
    const int wave = threadIdx.x >> 6, lane = threadIdx.x & 63;
    for (int row = wg * 8 + wave; row < MTOK; row += nwg * 8) {
        const f32x4* xr = (const f32x4*)(x + (size_t)row * 1024);
        float ss = 0.f;
#pragma unroll
        for (int i = 0; i < 4; ++i) {
            const f32x4 v = xr[lane + i * 64];
            ss += (v[0] * v[0] + v[1] * v[1]) + (v[2] * v[2] + v[3] * v[3]);
            u32x2 w; w.x = cvt_pk_bf16(v[0], v[1]); w.y = cvt_pk_bf16(v[2], v[3]);
            *(u32x2*)(xb + (size_t)row * 1024 + (lane + i * 64) * 4) = w;
        }
        ss = wave_sum(ss);
        if (lane < 16) rowss[(size_t)row * 16 + lane] = (lane == 0) ? ss : 0.f;
    }
}

__device__ __attribute__((noinline)) void final_norm(float* out, const float* rowss, const float* gain, int wg, int nwg) {
    const int wave = threadIdx.x >> 6, lane = threadIdx.x & 63;
    for (int row = wg * 8 + wave; row < MTOK; row += nwg * 8) {
        const float rs = row_rs(rowss, row);
        f32x4* xr = (f32x4*)(out + (size_t)row * 1024);
        const f32x4* gp = (const f32x4*)gain;
#pragma unroll
        for (int i = 0; i < 4; ++i) { const f32x4 v = xr[lane + i * 64], g4 = gp[lane + i * 64]; xr[lane + i * 64] = v * rs * g4; }
    }
}

__device__ __attribute__((noinline)) void gla_prep(LAS unsigned char* lds, bf16_t* QK, bf16_t* KENDT, float* DEC, const float* wgu  , const float* bg  , int wg, int nwg) {
    const int tid = threadIdx.x, d = tid & 127, sq = tid >> 7;
    LAS float* rS = (LAS float*)lds;
    LAS float* tot = rS + 1024;
    for (int item = wg; item < 1024; item += nwg) {
        const int n = item & 31, h = (item >> 5) & 3, b = item >> 7;
        const size_t m0 = (size_t)b * SEQ + n * 64;
#pragma unroll
        for (int i = 0; i < 2; ++i) { const int idx = tid + i * 512, s = idx >> 4, j = idx & 15; rS[idx] = bf2f(QK[(m0 + s) * 1280 + 1024 + j]); }
        float w[16];
#pragma unroll
        for (int j = 0; j < 16; ++j) w[j] = wgu[j * 512 + h * 128 + d];
        const float bb = bg[h * 128 + d];
        __syncthreads();
        float c[16]; float run = 0.f;
#pragma unroll
        for (int i = 0; i < 16; ++i) {
            const int s = sq * 16 + i; float g = bb;
#pragma unroll
            for (int j = 0; j < 16; ++j) g += rS[s * 16 + j] * w[j];
            const float la = (fminf(g, 0.f) - log1pf(expf(-fabsf(g)))) * (1.0f / 16.0f);
            run += la; c[i] = run;
        }
        tot[sq * 128 + d] = run;
        __syncthreads();
        float off = 0.f, blast = 0.f;
#pragma unroll
        for (int qd = 0; qd < 4; ++qd) { const float t = tot[qd * 128 + d]; blast += t; if (qd < sq) off += t; }
        unsigned ke[8];
#pragma unroll
        for (int i = 0; i < 16; i += 2) {
            float kev[2];
#pragma unroll
            for (int e = 0; e < 2; ++e) {
                const int s = sq * 16 + i + e; const float bc = off + c[i + e];
                const size_t a = (m0 + s) * 1280 + h * 128 + d;
                const float q = bf2f(QK[a]), k = bf2f(QK[a + 512]);
                QK[a] = f2bf(q * expf(bc) * 0.08838834764831845f);
                QK[a + 512] = f2bf(k * expf(-bc));
                kev[e] = k * expf(blast - bc);
            }
            ke[i >> 1] = cvt_pk_bf16(kev[0], kev[1]);
        }
        u32x4* kd = (u32x4*)(KENDT + ((size_t)item * 128 + d) * 64 + sq * 16);
        kd[0] = (u32x4){ke[0], ke[1], ke[2], ke[3]}; kd[1] = (u32x4){ke[4], ke[5], ke[6], ke[7]};
        if (sq == 0) DEC[item * 128 + d] = expf(blast);
        __syncthreads();
    }
}

__device__ __attribute__((noinline)) void gla_scan(LAS unsigned char* lds, bf16_t* PA, const bf16_t* QK, const bf16_t* KENDT, const float* DEC, float* SSQ, int wg, int nwg) {
    const int tid = threadIdx.x, wave = __builtin_amdgcn_readfirstlane(tid >> 6), lane = tid & 63, fr = lane & 15, fq = lane >> 4;
    LAS bf16_t* Qs = (LAS bf16_t*)lds;
    LAS bf16_t* Ks = (LAS bf16_t*)(lds + 17408);
    LAS bf16_t* KEs = (LAS bf16_t*)(lds + 34816);
    LAS bf16_t* Vt = (LAS bf16_t*)(lds + 53248);
    LAS bf16_t* As = (LAS bf16_t*)(lds + 62464);
    LAS bf16_t* St = (LAS bf16_t*)(lds + 71680);
    LAS float* decs = (LAS float*)(lds + 89088);
    for (int item = wg; item < 256; item += nwg) {
        const int vs = item & 7, h = (item >> 3) & 3, b = item >> 5;
        f32x4 S[4];
#pragma unroll
        for (int te = 0; te < 4; ++te) S[te] = (f32x4){0.f, 0.f, 0.f, 0.f};
        for (int i = tid; i < 64 * 136 / 2; i += 512) ((LAS unsigned*)St)[i] = 0u;
        __syncthreads();
        for (int n = 0; n < 32; ++n) {
            const int chunk = (b * 4 + h) * 32 + n; const size_t m0 = (size_t)b * SEQ + n * 64;
#pragma unroll
            for (int i = 0; i < 2; ++i) {
                const int p = tid + i * 512, row = p >> 4, c8 = p & 15;
                const bf16_t* src = QK + (m0 + row) * 1280 + h * 128 + c8 * 8;
                *(LAS u32x4*)(Qs + row * 136 + c8 * 8) = *(const u32x4*)src;
                *(LAS u32x4*)(Ks + row * 136 + c8 * 8) = *(const u32x4*)(src + 512);
                const int row2 = p >> 3, c82 = p & 7;
                *(LAS u32x4*)(KEs + row2 * 72 + c82 * 8) = *(const u32x4*)(KENDT + ((size_t)chunk * 128 + row2) * 64 + c82 * 8);
            }
            {
                const int s = tid >> 3, c8 = tid & 7;
                const u32x4 vv = *(const u32x4*)(PA + (m0 + s) * 4096 + h * 512 + vs * 64 + c8 * 8);
                const unsigned vw[4] = {vv.x, vv.y, vv.z, vv.w};
#pragma unroll
                for (int k = 0; k < 4; ++k) { Vt[(c8 * 8 + 2 * k) * 72 + s] = (bf16_t)(vw[k] & 0xffffu); Vt[(c8 * 8 + 2 * k + 1) * 72 + s] = (bf16_t)(vw[k] >> 16); }
            }
            if (tid < 128) decs[tid] = DEC[chunk * 128 + tid];
            __syncthreads();
#pragma unroll
            for (int q = 0; q < 2; ++q) {
                const int t = wave * 2 + q, tc = t >> 2, ts = t & 3;
                f32x4 a4 = (f32x4){0.f, 0.f, 0.f, 0.f};
#pragma unroll
                for (int kk = 0; kk < 4; ++kk) {
                    const bf16x8 ka = *(const LAS bf16x8*)(Ks + (ts * 16 + fr) * 136 + kk * 32 + fq * 8);
                    const bf16x8 qb = *(const LAS bf16x8*)(Qs + (tc * 16 + fr) * 136 + kk * 32 + fq * 8);
                    a4 = __builtin_amdgcn_mfma_f32_16x16x32_bf16(ka, qb, a4, 0, 0, 0);
                }
                const int c = tc * 16 + fr, s0 = ts * 16 + fq * 4;
                float v[4];
#pragma unroll
                for (int j = 0; j < 4; ++j) v[j] = (s0 + j <= c) ? a4[j] : 0.f;
                u32x2 w; w.x = cvt_pk_bf16(v[0], v[1]); w.y = cvt_pk_bf16(v[2], v[3]);
                *(LAS u32x2*)(As + c * 72 + s0) = w;
            }
            __syncthreads();
            {
                const int tc = wave >> 1; float ss = 0.f;
#pragma unroll
                for (int q = 0; q < 2; ++q) {
                    const int te = (wave & 1) * 2 + q;
                    f32x4 o4 = (f32x4){0.f, 0.f, 0.f, 0.f};
#pragma unroll
                    for (int kk = 0; kk < 2; ++kk) {
                        const bf16x8 va = *(const LAS bf16x8*)(Vt + (te * 16 + fr) * 72 + kk * 32 + fq * 8);
                        const bf16x8 ab = *(const LAS bf16x8*)(As + (tc * 16 + fr) * 72 + kk * 32 + fq * 8);
                        o4 = __builtin_amdgcn_mfma_f32_16x16x32_bf16(va, ab, o4, 0, 0, 0);
                    }
#pragma unroll
                    for (int kk = 0; kk < 4; ++kk) {
                        const bf16x8 sa = *(const LAS bf16x8*)(St + (te * 16 + fr) * 136 + kk * 32 + fq * 8);
                        const bf16x8 qb = *(const LAS bf16x8*)(Qs + (tc * 16 + fr) * 136 + kk * 32 + fq * 8);
                        o4 = __builtin_amdgcn_mfma_f32_16x16x32_bf16(sa, qb, o4, 0, 0, 0);
                    }
                    ss += (o4[0] * o4[0] + o4[1] * o4[1]) + (o4[2] * o4[2] + o4[3] * o4[3]);
                    u32x2 w; w.x = cvt_pk_bf16(o4[0], o4[1]); w.y = cvt_pk_bf16(o4[2], o4[3]);
                    *(u32x2*)(PA + (m0 + tc * 16 + fr) * 4096 + h * 512 + vs * 64 + te * 16 + fq * 4) = w;
                }
                ss += __shfl_xor(ss, 16); ss += __shfl_xor(ss, 32);
                if (fq == 0) SSQ[((m0 + tc * 16 + fr) * 4 + h) * 16 + vs * 2 + (wave & 1)] = ss;
            }
            {
                const f32x4 dv = *(const LAS f32x4*)(decs + wave * 16 + fq * 4);
#pragma unroll
                for (int te = 0; te < 4; ++te) {
                    S[te] = S[te] * dv;
#pragma unroll
                    for (int kk = 0; kk < 2; ++kk) {
                        const bf16x8 ka = *(const LAS bf16x8*)(KEs + (wave * 16 + fr) * 72 + kk * 32 + fq * 8);
                        const bf16x8 vb = *(const LAS bf16x8*)(Vt + (te * 16 + fr) * 72 + kk * 32 + fq * 8);
                        S[te] = __builtin_amdgcn_mfma_f32_16x16x32_bf16(ka, vb, S[te], 0, 0, 0);
                    }
                }
            }
            __syncthreads();
#pragma unroll
            for (int te = 0; te < 4; ++te) {
                u32x2 w; w.x = cvt_pk_bf16(S[te][0], S[te][1]); w.y = cvt_pk_bf16(S[te][2], S[te][3]);
                *(LAS u32x2*)(St + (te * 16 + fr) * 136 + wave * 16 + fq * 4) = w;
            }
        }
        __syncthreads();
    }
}

__device__ __attribute__((noinline)) void gla_gate(bf16_t* PA, const float* SSQ, const float* gain  , int wg, int nwg) {
    const size_t total = (size_t)MTOK * 256;
    for (size_t p = (size_t)wg * 512 + threadIdx.x; p < total; p += (size_t)nwg * 512) {
        const size_t m = p >> 8; const int col = (int)(p & 255) * 8, h = col >> 9, e = col & 511;
        const f32x4* sp = (const f32x4*)(SSQ + (m * 4 + h) * 16);
        const f32x4 s = (sp[0] + sp[1]) + (sp[2] + sp[3]);
        const float rs = rsqrtf(((s[0] + s[1]) + (s[2] + s[3])) * (1.0f / 512.0f) + EPS);
        bf16_t* op = PA + m * 4096 + col;
        const u32x4 ov = *(const u32x4*)op, zv = *(const u32x4*)(op + 2048);
        const f32x4 g0 = *(const f32x4*)(gain + e), g1 = *(const f32x4*)(gain + e + 4);
        const unsigned ow[4] = {ov.x, ov.y, ov.z, ov.w}, zw[4] = {zv.x, zv.y, zv.z, zv.w};
        const float gg[8] = {g0[0], g0[1], g0[2], g0[3], g1[0], g1[1], g1[2], g1[3]};
        unsigned r[4];
#pragma unroll
        for (int k = 0; k < 4; ++k) {
            const float oa = bflo(ow[k]), ob = bfhi(ow[k]), za = bflo(zw[k]), zb = bfhi(zw[k]);
            r[k] = cvt_pk_bf16(oa * rs * gg[2 * k] * (za * sigmoidf_(za)), ob * rs * gg[2 * k + 1] * (zb * sigmoidf_(zb)));
        }
        *(u32x4*)op = (u32x4){r[0], r[1], r[2], r[3]};
    }
}

__device__ __forceinline__ float gelu_tanh(float y) { return 0.5f * y * (1.0f + tanhf(0.7978845608028654f * (y + 0.044715f * y * y * y))); }
__device__ __attribute__((noinline)) void s5_simple(LAS unsigned char* lds, bf16_t* PA, const float* lam_re, const float* lam_im, const float* log_dt, const float* b_re, const float* b_im,
                                          const float* c_re, const float* c_im, const float* dsk, int wg, int nwg) {
    const int wave = threadIdx.x >> 6, lane = threadIdx.x & 63;
    if (wave < 4) {
        LAS float* cS = (LAS float*)lds + wave * 4416;
        LAS float* sS = cS + 2080;
        LAS float* uS = sS + 2080;
        for (int item = wg * 4 + wave; item < 1024; item += nwg * 4) {
            const int g = item & 127, b = item >> 7, p = lane;
            const float lr = lam_re[g * 64 + p], li = lam_im[g * 64 + p], dt = expf(log_dt[g]);
            const float mag = expf(lr * dt), ang = li * dt, lbr = mag * cosf(ang), lbi = mag * sinf(ang);
            const float nr = lbr - 1.0f, ni = lbi, den = lr * lr + li * li;
            const float bcr = (nr * lr + ni * li) / den, bci = (ni * lr - nr * li) / den;
            float Br[16], Bi[16];
#pragma unroll
            for (int j = 0; j < 16; ++j) { const float xr = b_re[(size_t)(g * 64 + p) * 16 + j], xi = b_im[(size_t)(g * 64 + p) * 16 + j]; Br[j] = bcr * xr - bci * xi; Bi[j] = bcr * xi + bci * xr; }
            __builtin_amdgcn_wave_barrier();
#pragma unroll
            for (int i = 0; i < 16; ++i) { cS[i * 65 + p] = c_re[(size_t)(g * 16 + i) * 64 + p]; cS[1040 + i * 65 + p] = c_im[(size_t)(g * 16 + i) * 64 + p]; }
            const int tt = lane >> 2, i0 = (lane & 3) * 4;
            float dk[4];
#pragma unroll
            for (int k = 0; k < 4; ++k) dk[k] = dsk[g * 16 + i0 + k];
            float sr = 0.f, si = 0.f;
            for (int t0 = 0; t0 < SEQ; t0 += 16) {
                const size_t m0 = (size_t)b * SEQ + t0;
                bf16_t* up = PA + (m0 + tt) * 4096 + g * 16 + i0;
                const u32x2 uv = *(const u32x2*)up;
                uS[tt * 16 + i0 + 0] = bflo(uv.x); uS[tt * 16 + i0 + 1] = bfhi(uv.x); uS[tt * 16 + i0 + 2] = bflo(uv.y); uS[tt * 16 + i0 + 3] = bfhi(uv.y);
                __builtin_amdgcn_fence(__ATOMIC_RELEASE, "wavefront"); __builtin_amdgcn_wave_barrier(); __builtin_amdgcn_fence(__ATOMIC_ACQUIRE, "wavefront");
#pragma unroll 4
                for (int t = 0; t < 16; ++t) {
                    float bur = 0.f, bui = 0.f;
#pragma unroll
                    for (int j = 0; j < 16; ++j) { const float uu = uS[t * 16 + j]; bur += Br[j] * uu; bui += Bi[j] * uu; }
                    const float nsr = lbr * sr - lbi * si + bur, nsi = lbr * si + lbi * sr + bui;
                    sr = nsr; si = nsi;
                    sS[t * 130 + 2 * p] = sr; sS[t * 130 + 2 * p + 1] = si;
                }
                __builtin_amdgcn_fence(__ATOMIC_RELEASE, "wavefront"); __builtin_amdgcn_wave_barrier(); __builtin_amdgcn_fence(__ATOMIC_ACQUIRE, "wavefront");
                float y[4] = {0.f, 0.f, 0.f, 0.f};
                for (int pp = 0; pp < 64; ++pp) {
                    const float re = sS[tt * 130 + 2 * pp], im = sS[tt * 130 + 2 * pp + 1];
#pragma unroll
                    for (int k = 0; k < 4; ++k) y[k] += re * cS[(i0 + k) * 65 + pp] - im * cS[1040 + (i0 + k) * 65 + pp];
                }
                float o[4];
#pragma unroll
                for (int k = 0; k < 4; ++k) o[k] = gelu_tanh(y[k] + dk[k] * uS[tt * 16 + i0 + k]);
                u32x2 w; w.x = cvt_pk_bf16(o[0], o[1]); w.y = cvt_pk_bf16(o[2], o[3]);
                *(u32x2*)up = w;
                __builtin_amdgcn_fence(__ATOMIC_RELEASE, "wavefront"); __builtin_amdgcn_wave_barrier(); __builtin_amdgcn_fence(__ATOMIC_ACQUIRE, "wavefront");
            }
        }
    }
}


__device__ __attribute__((noinline)) void s5_tables(LAS unsigned char* lds, bf16_t* BtY, bf16_t* BtF, const float* lam_re, const float* lam_im, const float* log_dt,
                                                    const float* b_re, const float* b_im, const float* c_re, const float* c_im, const float* dsk, int wg, int nwg) {
    const int tid = threadIdx.x;
    LAS float* Bb = (LAS float*)lds;
    LAS float* Cc = Bb + 2048;
    LAS float* Pw = Cc + 2048;
    LAS float* Kl = Pw + 2176;
    for (int item = wg; item < 256; item += nwg) {
        const int g = item >> 1, half = item & 1;
        const float dt = expf(log_dt[g]);
        for (int idx = tid; idx < 17 * 64; idx += 512) {
            const int d = idx >> 6, p = idx & 63;
            const float lr = lam_re[g * 64 + p], li = lam_im[g * 64 + p];
            const float mag = expf((float)d * lr * dt), ang = (float)d * (li * dt);
            Pw[idx * 2] = mag * cosf(ang); Pw[idx * 2 + 1] = mag * sinf(ang);
        }
        for (int idx = tid; idx < 1024; idx += 512) {
            const int p = idx >> 4, jj = idx & 15;
            const float lr = lam_re[g * 64 + p], li = lam_im[g * 64 + p];
            const float mag = expf(lr * dt), ang = li * dt, lbr = mag * cosf(ang), lbi = mag * sinf(ang);
            const float nr = lbr - 1.0f, ni = lbi, den = lr * lr + li * li;
            const float bcr = (nr * lr + ni * li) / den, bci = (ni * lr - nr * li) / den;
            const float xr = b_re[(size_t)(g * 64 + p) * 16 + jj], xi = b_im[(size_t)(g * 64 + p) * 16 + jj];
            Bb[idx * 2] = bcr * xr - bci * xi; Bb[idx * 2 + 1] = bcr * xi + bci * xr;
            const int i = idx >> 6, pp = idx & 63;
            Cc[idx * 2] = c_re[(size_t)(g * 16 + i) * 64 + pp]; Cc[idx * 2 + 1] = c_im[(size_t)(g * 16 + i) * 64 + pp];
        }
        __syncthreads();
        {
            const int ij = tid & 255, i = ij >> 4, jj = ij & 15;
            for (int d = tid >> 8; d < 16; d += 2) {
                float acc = 0.f;
                for (int p = 0; p < 64; ++p) {
                    const float cr = Cc[(i * 64 + p) * 2], ci = Cc[(i * 64 + p) * 2 + 1], pr = Pw[(d * 64 + p) * 2], pi = Pw[(d * 64 + p) * 2 + 1];
                    const float clr = cr * pr - ci * pi, cli = cr * pi + ci * pr;
                    acc += clr * Bb[(p * 16 + jj) * 2] - cli * Bb[(p * 16 + jj) * 2 + 1];
                }
                Kl[d * 256 + ij] = acc;
            }
        }
        __syncthreads();
        for (int idx = tid; idx < 128 * 128; idx += 512) {
            const int rl = idx >> 7, kp = idx & 127, t = half * 8 + (rl >> 4), i = rl & 15, k = 2 * kp, s = k >> 4, jj = k & 15;
            float v0 = 0.f, v1 = 0.f;
            if (s <= t) { v0 = Kl[(t - s) * 256 + i * 16 + jj]; v1 = Kl[(t - s) * 256 + i * 16 + jj + 1];
                if (s == t) { if (i == jj) v0 += dsk[g * 16 + i]; if (i == jj + 1) v1 += dsk[g * 16 + i]; } }
            *(unsigned*)(BtY + ((size_t)g * 256 + t * 16 + i) * 384 + k) = cvt_pk_bf16(v0, v1);
        }
        for (int idx = tid; idx < 128 * 64; idx += 512) {
            const int rl = idx >> 6, kp = idx & 63, t = half * 8 + (rl >> 4), i = rl & 15, k2 = 2 * kp, part = k2 >> 6, p = k2 & 63;
            float v[2];
#pragma unroll
            for (int e = 0; e < 2; ++e) {
                const float cr = Cc[(i * 64 + p + e) * 2], ci = Cc[(i * 64 + p + e) * 2 + 1], pr = Pw[((t + 1) * 64 + p + e) * 2], pi = Pw[((t + 1) * 64 + p + e) * 2 + 1];
                v[e] = part == 0 ? (cr * pr - ci * pi) : -(cr * pi + ci * pr);
            }
            *(unsigned*)(BtY + ((size_t)g * 256 + t * 16 + i) * 384 + 256 + k2) = cvt_pk_bf16(v[0], v[1]);
        }
        for (int idx = tid; idx < 64 * 128; idx += 512) {
            const int p = idx >> 7, kp = idx & 127, k = 2 * kp, s = k >> 4, jj = k & 15;
            const float pr = Pw[((15 - s) * 64 + p) * 2], pi = Pw[((15 - s) * 64 + p) * 2 + 1];
            float v[2];
#pragma unroll
            for (int e = 0; e < 2; ++e) { const float br = Bb[(p * 16 + jj + e) * 2], bi = Bb[(p * 16 + jj + e) * 2 + 1]; v[e] = half == 0 ? (pr * br - pi * bi) : (pr * bi + pi * br); }
            *(unsigned*)(BtF + ((size_t)g * 128 + half * 64 + p) * 256 + k) = cvt_pk_bf16(v[0], v[1]);
        }
        __syncthreads();
    }
}

__device__ __attribute__((noinline)) void s5_ssm(LAS unsigned char* lds, bf16_t* PA, const bf16_t* BtY, const bf16_t* BtF, const float* lam_re, const float* lam_im, const float* log_dt, int wg, int nwg) {
    const int tid = threadIdx.x, wave = __builtin_amdgcn_readfirstlane(tid >> 6), lane = tid & 63, fr = lane & 15, fq = lane >> 4;
    LAS bf16_t* Us = (LAS bf16_t*)lds;
    LAS bf16_t* Fs = (LAS bf16_t*)(lds + 67584);
    for (int item = wg; item < 1024; item += nwg) {
        const int g = item >> 3, b = item & 7;
#pragma unroll
        for (int r = 0; r < 8; ++r) {
            const int q = tid + r * 512, tl = q >> 1, hf = q & 1, c = tl >> 4, s = tl & 15;
            *(LAS u32x4*)(Us + c * 264 + s * 16 + hf * 8) = *(const u32x4*)(PA + ((size_t)b * SEQ + tl) * 4096 + g * 16 + hf * 8);
        }
        bf16x8 bf[8];
#pragma unroll
        for (int kk = 0; kk < 8; ++kk) bf[kk] = *(const bf16x8*)(BtF + ((size_t)g * 128 + wave * 16 + fr) * 256 + kk * 32 + fq * 8);
        __syncthreads();
#pragma unroll 2
        for (int mt = 0; mt < 8; ++mt) {
            f32x4 a4 = (f32x4){0.f, 0.f, 0.f, 0.f};
#pragma unroll
            for (int kk = 0; kk < 8; ++kk) {
                const bf16x8 ua = *(const LAS bf16x8*)(Us + (mt * 16 + fr) * 264 + kk * 32 + fq * 8);
                a4 = __builtin_amdgcn_mfma_f32_16x16x32_bf16(bf[kk], ua, a4, 0, 0, 0);
            }
            u32x2 w; w.x = cvt_pk_bf16(a4[0], a4[1]); w.y = cvt_pk_bf16(a4[2], a4[3]);
            *(LAS u32x2*)(Fs + (mt * 16 + fr) * 136 + wave * 16 + fq * 4) = w;
        }
        __syncthreads();
        if (tid < 64) {
            const int p = tid;
            const float lr = lam_re[g * 64 + p], li = lam_im[g * 64 + p], dt = expf(log_dt[g]);
            const float mag = expf(16.0f * lr * dt), ang = 16.0f * (li * dt), l16r = mag * cosf(ang), l16i = mag * sinf(ang);
            float sr = 0.f, si = 0.f;
            for (int c0 = 0; c0 < 128; c0 += 8) {
                float fre[8], fim[8];
#pragma unroll
                for (int e = 0; e < 8; ++e) { fre[e] = bf2f(Fs[(c0 + e) * 136 + p]); fim[e] = bf2f(Fs[(c0 + e) * 136 + 64 + p]); }
#pragma unroll
                for (int e = 0; e < 8; ++e) {
                    Fs[(c0 + e) * 136 + p] = f2bf(sr); Fs[(c0 + e) * 136 + 64 + p] = f2bf(si);
                    const float nsr = l16r * sr - l16i * si + fre[e], nsi = l16r * si + l16i * sr + fim[e];
                    sr = nsr; si = nsi;
                }
            }
        }
        __syncthreads();
#pragma unroll 1
        for (int q = 0; q < 2; ++q) {
            const int t = q == 0 ? wave : 15 - wave, nks = (t >> 1) + 1, nk = nks + 4;
            const bf16_t* brow = BtY + ((size_t)g * 256 + t * 16 + fr) * 384 + fq * 8;
            f32x4 acc[8];
#pragma unroll
            for (int mt = 0; mt < 8; ++mt) acc[mt] = (f32x4){0.f, 0.f, 0.f, 0.f};
            bf16x8 bcur = *(const bf16x8*)brow;
            for (int kk = 0; kk < nk; ++kk) {
                const int kn = kk + 1;
                const int koffn = (kn < nks) ? kn * 32 : 256 + (kn - nks) * 32;
                const bf16x8 bnext = (kn < nk) ? *(const bf16x8*)(brow + koffn) : bcur;
                const LAS bf16_t* abase = (kk < nks) ? (Us + fr * 264 + kk * 32 + fq * 8) : (Fs + fr * 136 + (kk - nks) * 32 + fq * 8);
                const int astride = (kk < nks) ? 16 * 264 : 16 * 136;
#pragma unroll
                for (int mt = 0; mt < 8; ++mt) {
                    const bf16x8 ua = *(const LAS bf16x8*)(abase + mt * astride);
                    acc[mt] = __builtin_amdgcn_mfma_f32_16x16x32_bf16(bcur, ua, acc[mt], 0, 0, 0);
                }
                bcur = bnext;
            }
#pragma unroll
            for (int mt = 0; mt < 8; ++mt) {
                u32x2 w; w.x = cvt_pk_bf16(gelu_tanh(acc[mt][0]), gelu_tanh(acc[mt][1])); w.y = cvt_pk_bf16(gelu_tanh(acc[mt][2]), gelu_tanh(acc[mt][3]));
                *(u32x2*)(PA + ((size_t)b * SEQ + (mt * 16 + fr) * 16 + t) * 4096 + g * 16 + fq * 4) = w;
            }
        }
        __syncthreads();
    }
}

struct Params { const float* in[21]; float* out; unsigned char* ws; };

__global__ void __launch_bounds__(512, 2) fwd_megakernel(Params P) {
    extern __shared__ __attribute__((aligned(16))) unsigned char lds_raw[];
    LAS unsigned char* lds = (LAS unsigned char*)lds_raw;
    cg::grid_group grid = cg::this_grid();
    volatile LAS unsigned* xst = (volatile LAS unsigned*)(lds + 131072);
    if (threadIdx.x < 4) xst[threadIdx.x] = 0u;
    __syncthreads();
    unsigned* barw = (unsigned*)(P.ws + WS_BAR);
    const XcdBarrier xb = xcd_barrier_post(barw, xst);
#define GSYNC() xcd_barrier(xb.bar, xb.x, xb.st)
    const int wg = blockIdx.x, nwg = gridDim.x;
    unsigned char* ws = P.ws;
    bf16_t* WGLA_IN = (bf16_t*)(ws + WS_WGLA_IN); bf16_t* WGLA_OUT = (bf16_t*)(ws + WS_WGLA_OUT);
    bf16_t* WS5_IN = (bf16_t*)(ws + WS_WS5_IN); bf16_t* WS5_GLU = (bf16_t*)(ws + WS_WS5_GLU); bf16_t* WS5_OUT = (bf16_t*)(ws + WS_WS5_OUT);
    bf16_t* XB = (bf16_t*)(ws + WS_XB); bf16_t* KENDT = XB;
    bf16_t* PA = (bf16_t*)(ws + WS_PA); bf16_t* QK = (bf16_t*)(ws + WS_QK);
    bf16_t* BTY = (bf16_t*)(ws + WS_BTY); bf16_t* BTF = (bf16_t*)(ws + WS_BTF);
    float* RSS = (float*)(ws + WS_RSS); float* DEC = (float*)(ws + WS_DEC); float* SSQ = (float*)(ws + WS_SSQ);
    const float* x = P.in[0];
    float* out = P.out;

    convert_wt(lds, P.in[2], P.in[1], WGLA_IN, 1024, GLA_IN, GLA_NP, wg, nwg);
    convert_wt(lds, P.in[6], nullptr, WGLA_OUT, 2048, 1024, 1024, wg, nwg);
    convert_wt(lds, P.in[8], P.in[7], WS5_IN, 1024, 4096, 4096, wg, nwg);
    convert_wt(lds, P.in[17], nullptr, WS5_GLU, 2048, 2048, 2048, wg, nwg);
    convert_wt(lds, P.in[19], nullptr, WS5_OUT, 2048, 1024, 1024, wg, nwg);
    xprep(x, XB, RSS, wg, nwg);
    grid.sync();

    for (int layer = 0; layer < 4; ++layer) {
        const int j = layer >> 1;
        const bool is_s5 = (layer & 1) != 0;
        const float* resid = (layer == 0) ? x : out;
        if (is_s5)
            s5_tables(lds, BTY, BTF, P.in[9] + (size_t)j * 128 * 64, P.in[10] + (size_t)j * 128 * 64, P.in[11] + (size_t)j * 128,
                      P.in[12] + (size_t)j * 128 * 64 * 16, P.in[13] + (size_t)j * 128 * 64 * 16,
                      P.in[14] + (size_t)j * 128 * 16 * 64, P.in[15] + (size_t)j * 128 * 16 * 64, P.in[16] + (size_t)j * 128 * 16, wg, nwg);
        { pg8::Gemm g{XB, is_s5 ? WS5_IN : WGLA_IN, MTOK, is_s5 ? 4096 : GLA_NP, 1024, 1024}; pg8::StaticOrder S; S.init(MTOK, g.N, nwg, wg);
          EpiProj E{PA, QK, RSS, is_s5 ? 0 : 4, is_s5 ? 16 : 20}; pg8::gemm_phase<EpiProj>(lds, g, S, E); }
        GSYNC();
        if (!is_s5) {
            if (layer == 2) {
                convert_wt(lds, P.in[8] + (size_t)1024 * 4096, P.in[7] + 1024, WS5_IN, 1024, 4096, 4096, wg, nwg);
                convert_wt(lds, P.in[17] + (size_t)2048 * 2048, nullptr, WS5_GLU, 2048, 2048, 2048, wg, nwg);
                convert_wt(lds, P.in[19] + (size_t)2048 * 1024, nullptr, WS5_OUT, 2048, 1024, 1024, wg, nwg);
            }
            gla_prep(lds, QK, KENDT, DEC, P.in[3] + (size_t)j * 16 * 512, P.in[4] + (size_t)j * 512, wg, nwg);
            GSYNC();
            gla_scan(lds, PA, QK, KENDT, DEC, SSQ, wg, nwg);
            GSYNC();
            gla_gate(PA, SSQ, P.in[5] + (size_t)j * 512, wg, nwg);
            GSYNC();
        } else {
            if (layer == 1) {
                convert_wt(lds, P.in[2] + (size_t)1024 * GLA_IN, P.in[1] + 1024, WGLA_IN, 1024, GLA_IN, GLA_NP, wg, nwg);
                convert_wt(lds, P.in[6] + (size_t)2048 * 1024, nullptr, WGLA_OUT, 2048, 1024, 1024, wg, nwg);
            }
            s5_ssm(lds, PA, BTY, BTF, P.in[9] + (size_t)j * 128 * 64, P.in[10] + (size_t)j * 128 * 64, P.in[11] + (size_t)j * 128, wg, nwg);
            GSYNC();
            { pg8::Gemm g{PA, WS5_GLU, MTOK, 2048, 2048, 4096}; pg8::StaticOrder S; S.init(MTOK, 2048, nwg, wg);
              EpiGlu E{PA, P.in[18] + (size_t)j * 2048}; pg8::gemm_phase<EpiGlu>(lds, g, S, E); }
            GSYNC();
        }
        { pg8::Gemm g{is_s5 ? PA + 2048 : PA, is_s5 ? WS5_OUT : WGLA_OUT, MTOK, 1024, 2048, 4096}; pg8::StaticOrder S; S.init(MTOK, 1024, nwg, wg);
          EpiOut E{resid, out, XB, RSS}; pg8::gemm_phase<EpiOut>(lds, g, S, E); }
        GSYNC();
    }
    final_norm(out, RSS, P.in[20], wg, nwg);
}

extern "C" void kernel_launch(void* const* d_in, const int* in_sizes, int n_in, void* d_out, int out_size, void* d_ws, size_t ws_size, hipStream_t stream) {
    static int grid_blocks = 0;
    if (!grid_blocks) {
        int dev = 0, cus = 0, per_cu = 0;
        (void)hipGetDevice(&dev);
        (void)hipDeviceGetAttribute(&cus, hipDeviceAttributeMultiprocessorCount, dev);
        (void)hipFuncSetAttribute((const void*)fwd_megakernel, hipFuncAttributeMaxDynamicSharedMemorySize, LDS_BYTES);
        (void)hipOccupancyMaxActiveBlocksPerMultiprocessor(&per_cu, (const void*)fwd_megakernel, 512, LDS_BYTES);
        if (per_cu < 1) { fprintf(stderr, "occupancy query returned %d\n", per_cu); per_cu = 1; }
        if (per_cu > 1) per_cu = 1;
        grid_blocks = cus * per_cu;
        if (ws_size < WS_END) fprintf(stderr, "workspace too small: %zu < %zu\n", ws_size, (size_t)WS_END);
    }
    (void)hipMemsetAsync((char*)d_ws + WS_BAR, 0, 16384, stream);
    Params p{};
    for (int i = 0; i < 21; ++i) p.in[i] = (const float*)d_in[i];
    p.out = (float*)d_out; p.ws = (unsigned char*)d_ws;
    void* args[] = {&p};
    hipError_t e = hipLaunchCooperativeKernel((void*)fwd_megakernel, dim3(grid_blocks), dim3(512), args, LDS_BYTES, stream);
    if (e != hipSuccess) fprintf(stderr, "cooperative launch failed: %s (grid %d)\n", hipGetErrorString(e), grid_blocks);
}
```

```cpp
#include <hip/hip_runtime.h>
#include <hip/hip_cooperative_groups.h>
#include <cstdio>
namespace cg = cooperative_groups;

#define LAS __attribute__((address_space(3)))
#define GAS __attribute__((address_space(1)))
typedef unsigned short bf16_t;
typedef short bf16x8 __attribute__((ext_vector_type(8)));
typedef float f32x4 __attribute__((ext_vector_type(4)));
typedef float f32x2 __attribute__((ext_vector_type(2)));
typedef unsigned u32x4 __attribute__((ext_vector_type(4)));
typedef unsigned u32x2 __attribute__((ext_vector_type(2)));

constexpr int MTOK = 16384, DM = 1024, DI = 2048, SEQ = 2048;
constexpr int GLA_IN = 5136, GLA_NP = 5376;
constexpr float EPS = 1e-6f;
constexpr int LDP = 4160;
constexpr int RAT_OFF = 131072 + 64;
constexpr int LDS_BYTES = RAT_OFF + 4096;

constexpr size_t WS_WGLA_IN = 0;
constexpr size_t WS_WGLA_OUT = WS_WGLA_IN + (size_t)GLA_NP * 1024 * 2;
constexpr size_t WS_WS5_IN = WS_WGLA_OUT + (size_t)1024 * 2048 * 2;
constexpr size_t WS_WS5_GLU = WS_WS5_IN + (size_t)4096 * 1024 * 2;
constexpr size_t WS_WS5_OUT = WS_WS5_GLU + (size_t)2048 * 2048 * 2;
constexpr size_t WS_XB = WS_WS5_OUT + (size_t)1024 * 2048 * 2;
constexpr size_t WS_PA = WS_XB + (size_t)MTOK * 1024 * 2;
constexpr size_t WS_QK = WS_PA + (size_t)MTOK * LDP * 2;
constexpr size_t WS_RSS = WS_QK + (size_t)MTOK * 1280 * 2;
constexpr size_t WS_DEC = WS_RSS + (size_t)MTOK * 16 * 4;
constexpr size_t WS_SSQ = WS_DEC + (size_t)1024 * 128 * 4;
constexpr size_t WS_BAR = WS_SSQ + (size_t)MTOK * 64 * 4;
constexpr size_t WS_L16 = WS_BAR + 16384;
constexpr size_t WS_END = WS_L16 + 128 * 64 * 2 * 4;
constexpr size_t WS_BTY = WS_QK;
constexpr size_t WS_BTF = WS_BTY + (size_t)128 * 256 * 384 * 2;
static_assert(WS_BTF + (size_t)128 * 128 * 256 * 2 <= WS_RSS, "S5 tables must fit in the QK region");
static_assert(WS_END <= (size_t)256 * 1024 * 1024, "workspace budget");

__device__ __forceinline__ float bf2f(bf16_t b) { return __uint_as_float(((unsigned)b) << 16); }
__device__ __forceinline__ float bflo(unsigned w) { return __uint_as_float(w << 16); }
__device__ __forceinline__ float bfhi(unsigned w) { return __uint_as_float(w & 0xffff0000u); }
typedef __bf16 bf16x2_t __attribute__((ext_vector_type(2)));
__device__ __forceinline__ unsigned cvt_pk_bf16(float lo, float hi) { const f32x2 v = {lo, hi}; const bf16x2_t r = __builtin_convertvector(v, bf16x2_t); return __builtin_bit_cast(unsigned, r); }
__device__ __forceinline__ bf16_t f2bf(float f) { return (bf16_t)(cvt_pk_bf16(f, 0.f) & 0xffffu); }
__device__ __forceinline__ float sigmoidf_(float x) { return 1.0f / (1.0f + __expf(-x)); }
__device__ __forceinline__ float wave_sum(float v) {
#pragma unroll
    for (int o = 32; o > 0; o >>= 1) v += __shfl_xor(v, o);
    return v;
}


#define XB_TMO      128
#define XB_XCNT(j)  (256  + 64 * (j))
#define XB_XSUB(j)  (1280 + 64 * (j))
#define XB_XGEN(j)  (2304 + 64 * (j))
#define XB_TOP      3328
#define XB_TOPGEN   3392
#define XCD_BAR_WORDS 3456
#define XB_SPIN_CAP (1u << 18)
__device__ __forceinline__ unsigned xb_ld(unsigned* p)              { return __hip_atomic_load(p, __ATOMIC_RELAXED, __HIP_MEMORY_SCOPE_AGENT); }
__device__ __forceinline__ unsigned xb_add(unsigned* p, unsigned v) { return __hip_atomic_fetch_add(p, v, __ATOMIC_RELAXED, __HIP_MEMORY_SCOPE_AGENT); }
__device__ __forceinline__ unsigned xb_xcc_id() { return (unsigned)__builtin_amdgcn_s_getreg((3 << 11) | 20) & 0xFu; }
#define XB_SPIN(cond, bar) do { unsigned _sp = 0; while (cond) { __builtin_amdgcn_s_sleep(1); \
    if ((++_sp & 255u) == 0u) { if (xb_ld(&(bar)[XB_TMO])) break; if (_sp > XB_SPIN_CAP) { atomicAdd(&(bar)[XB_TMO], 1u); break; } } } } while (0)
struct XcdBarrier { unsigned* bar; unsigned x; volatile LAS unsigned* st; };
__device__ __forceinline__ XcdBarrier xcd_barrier_post(unsigned* bar, volatile LAS unsigned* st) {
    XcdBarrier b; b.bar = bar; b.x = xb_xcc_id(); b.st = st;
    if (threadIdx.x == 0) (void)xb_add(&bar[XB_XCNT(b.x)], 1u);
    return b;
}
__device__ __forceinline__ void xcd_barrier_complete(unsigned* bar, unsigned x, unsigned& nloc, unsigned& nx) {
    const unsigned G = gridDim.x * gridDim.y * gridDim.z;
    unsigned sum, cnt, mine, sp = 0u;
    for (;;) {
        sum = 0u; cnt = 0u; mine = 0u;
#pragma unroll
        for (unsigned j = 0; j < 16; ++j) { const unsigned c = xb_ld(&bar[XB_XCNT(j)]); sum += c; cnt += (c > 0u) ? 1u : 0u; mine = (j == x) ? c : mine; }
        if (sum == G) break;
        __builtin_amdgcn_s_sleep(1);
        if ((++sp & 255u) == 0u) { if (xb_ld(&bar[XB_TMO])) break; if (sp > XB_SPIN_CAP) { atomicAdd(&bar[XB_TMO], 1u); break; } }
    }
    nloc = mine > 0u ? mine : 1u; nx = cnt > 0u ? cnt : 1u;
}
__device__ __attribute__((noinline)) void xcd_barrier(unsigned* bar, unsigned x, volatile LAS unsigned* st) {
    asm volatile("s_waitcnt vmcnt(0)" ::: "memory");
    __syncthreads();
    if (threadIdx.x == 0) {
        __builtin_amdgcn_s_waitcnt(0);
        unsigned nloc = st[0], nx = st[1];
        if (nloc == 0u) { xcd_barrier_complete(bar, x, nloc, nx); st[0] = nloc; st[1] = nx; }
        const unsigned old = xb_add(&bar[XB_XSUB(x)], 1u);
        const unsigned gen = old / nloc;
        if (old + 1u == (gen + 1u) * nloc) {
            __builtin_amdgcn_fence(__ATOMIC_RELEASE, "agent");
            asm volatile("s_waitcnt vmcnt(0)" ::: "memory");
            const unsigned og = xb_add(&bar[XB_TOP], 1u);
            const unsigned tg = og / nx;
            if (og + 1u == (tg + 1u) * nx) xb_add(&bar[XB_TOPGEN], 1u);
            else XB_SPIN(xb_ld(&bar[XB_TOPGEN]) == tg, bar);
            __builtin_amdgcn_fence(__ATOMIC_ACQUIRE, "agent");
            xb_add(&bar[XB_XGEN(x)], 1u);
            asm volatile("s_waitcnt vmcnt(0)" ::: "memory");
        } else {
            XB_SPIN(xb_ld(&bar[XB_XGEN(x)]) == gen, bar);
            __builtin_amdgcn_fence(__ATOMIC_ACQUIRE, "agent");
            asm volatile("s_waitcnt vmcnt(0)" ::: "memory");
        }
    }
    __syncthreads();
}

namespace pg8 {
constexpr int BM = 256, BK = 64, HALF = 128, HTB = HALF * BK * 2, STAGE_BYTES = 8 * HTB, NXCD = 8, WGM = 4;
__host__ __device__ __forceinline__ int lds_byte(int r, int c) { const int st = (r >> 4) * 2 + (c >> 5), rr = r & 15, cc = c & 31, ob = rr * 64 + cc * 2; return st * 1024 + (ob ^ (((ob >> 9) & 1) << 5)); }
__host__ __device__ __forceinline__ void stage_rc(int b, int& R, int& C) { const int st = b / 1024, sb = b % 1024, swz = sb ^ (((sb >> 9) & 1) << 5); R = (st >> 1) * 16 + swz / 64; C = (st & 1) * 32 + (swz % 64) / 2; }
__host__ __device__ __forceinline__ int perm32(int rho) { const int n = rho >> 4, i = rho & 15; return 8 * (i >> 2) + 4 * n + (i & 3); }

struct Unit { int pm, pn; };
struct Gemm { const bf16_t* A; const bf16_t* Bt; int M, N, K, lda; };

struct StaticOrder {
    int nM, nN, nwg, G, c;
    __host__ __device__ void init(int M, int N, int G_, int c_) { nM = M / BM; nN = N / BM; nwg = nM * nN; G = G_; c = c_; }
    __host__ __device__ bool next(int i, Unit& u) const {
        const long L = (long)i * G + c; if (L >= nwg) return false;
        int wgid = (int)L; { const int q = nwg / NXCD, r = nwg % NXCD, xcd = wgid % NXCD, off = wgid / NXCD; wgid = (xcd < r ? xcd * (q + 1) : r * (q + 1) + (xcd - r) * q) + off; }
        const int nig = WGM * nN, gid = wgid / nig, fm = gid * WGM, gsz = (nM - fm) < WGM ? (nM - fm) : WGM;
        u.pm = fm + ((wgid % nig) % gsz); u.pn = (wgid % nig) / gsz; return true;
    }
};

template <class Epi, bool ALIGN_EPI>
__device__ __forceinline__ void gemm_phase(LAS unsigned char* lds, const Gemm g, const StaticOrder& S, const Epi& E, const bool hs = false) {
    const LAS float* rat = (const LAS float*)(lds + RAT_OFF);
    int tid_ = threadIdx.x; asm volatile("" : "+v"(tid_));
    const int tid = tid_, wid = __builtin_amdgcn_readfirstlane(tid >> 6), lane = tid & 63, wr = wid >> 2, wc = wid & 3, fr = lane & 15, fq = lane >> 4;
    const int K = g.K, nt = K / BK, lda = g.lda;
    unsigned voffA, voffB;
    { int R, C; stage_rc(tid * 16, R, C); const int Rb = Epi::PERM ? ((R & ~31) + perm32(R & 31)) : R;
      voffA = (unsigned)(R * lda + C) * 2u; voffB = (unsigned)(Rb * K + C) * 2u; }
    const size_t rsvoffA = (size_t)64 * lda * 2, rsvoffB = (size_t)64 * K * 2; typedef char voffA_tag; typedef char voffB_tag;
    const size_t kstep = (size_t)(BK * 2);
    const size_t hstepA = (size_t)HALF * lda * 2, hstepB = (size_t)HALF * K * 2;
    const size_t tstepA = 2 * hstepA, tstepB = 2 * hstepB;
    const unsigned ldsw = (unsigned)wid * 1024u;
    const int aoff = lds_byte(wr * 64 + fr, fq * 8), boff = lds_byte(wc * 32 + fr, fq * 8);
#define PG8_SA(b, h) (((b) * 2 + (h)) * HTB)
#define PG8_SB(b, h) ((4 + (b) * 2 + (h)) * HTB)
#define PG8_STAGE(bufoff, gbase, voff) do { \
        __builtin_amdgcn_global_load_lds((const unsigned*)((const char*)(gbase) + (voff)), (LAS unsigned*)(lds + (bufoff) + ldsw), 16, 0, 0); \
        __builtin_amdgcn_global_load_lds((const unsigned*)((const char*)(gbase) + (sizeof(voff##_tag) ? rs##voff : 0) + (voff)), (LAS unsigned*)(lds + (bufoff) + ldsw + 8192), 16, 0, 0); } while (0)
#define PG8_LDA(dst, b, h) do { _Pragma("unroll") for (int m = 0; m < 4; ++m) _Pragma("unroll") for (int k = 0; k < 2; ++k) dst[m][k] = *(const LAS bf16x8*)(lds + PG8_SA(b, h) + aoff + m * 2048 + k * 1024); } while (0)
#define PG8_LDB(dst, b, h) do { _Pragma("unroll") for (int n = 0; n < 2; ++n) _Pragma("unroll") for (int k = 0; k < 2; ++k) dst[n][k] = *(const LAS bf16x8*)(lds + PG8_SB(b, h) + boff + n * 2048 + k * 1024); } while (0)
#define PG8_MMA(ai, bj, At, Bt) do { __builtin_amdgcn_s_setprio(1); _Pragma("unroll") for (int m = 0; m < 4; ++m) _Pragma("unroll") for (int n = 0; n < 2; ++n) _Pragma("unroll") for (int k = 0; k < 2; ++k) \
        acc[ai][bj][m][n] = __builtin_amdgcn_mfma_f32_16x16x32_bf16(Bt[n][k], At[m][k], acc[ai][bj][m][n], 0, 0, 0); __builtin_amdgcn_s_setprio(0); } while (0)
#define PG8_WAIT_V(n) asm volatile("s_waitcnt vmcnt(" #n ")" ::: "memory")
#define PG8_WAIT_L(n) asm volatile("s_waitcnt lgkmcnt(" #n ")" ::: "memory")
#define PG8_BAR __builtin_amdgcn_s_barrier()
#define PG8_SCHED __builtin_amdgcn_sched_barrier(0)
    Unit cur, nxt; int ui = 0;
    if (!S.next(0, cur)) return;
    f32x4 acc[2][2][4][2];
#pragma unroll
    for (int a = 0; a < 2; ++a)
#pragma unroll
        for (int b = 0; b < 2; ++b)
#pragma unroll
            for (int m = 0; m < 4; ++m)
#pragma unroll
                for (int n = 0; n < 2; ++n) acc[a][b][m][n] = (f32x4){0.f, 0.f, 0.f, 0.f};
    bf16x8 At[4][2], B0[2][2], B1[2][2];
    const char* cA = (const char*)g.A + (size_t)cur.pm * tstepA; const char* cB = (const char*)g.Bt + (size_t)cur.pn * tstepB;
    PG8_STAGE(PG8_SB(0, 0), cB, voffB); PG8_STAGE(PG8_SB(0, 1), cB + hstepB, voffB); PG8_STAGE(PG8_SA(0, 0), cA, voffA); PG8_STAGE(PG8_SA(0, 1), cA + hstepA, voffA);
    if (wr == 1) PG8_BAR;
    PG8_WAIT_V(2); PG8_BAR;
    PG8_STAGE(PG8_SB(1, 0), cB + kstep, voffB); PG8_STAGE(PG8_SA(1, 0), cA + kstep, voffA); PG8_STAGE(PG8_SB(1, 1), cB + hstepB + kstep, voffB);
    PG8_WAIT_V(6); PG8_BAR;
    for (;;) {
        const bool has_next = S.next(ui + 1, nxt);
        const char* nA = has_next ? (const char*)g.A + (size_t)nxt.pm * tstepA : cA; const char* nB = has_next ? (const char*)g.Bt + (size_t)nxt.pn * tstepB : cB;
        for (int t = 0; t < nt; t += 2) {
            const bool last = (t == nt - 2);
            const char* a1 = cA + (size_t)(t + 1) * kstep;
            const char* a2 = last ? nA : cA + (size_t)(t + 2) * kstep; const char* b2 = last ? nB : cB + (size_t)(t + 2) * kstep;
            const char* a3 = a2 + kstep; const char* b3 = b2 + kstep;
            if (hs && t != 0 && (t & 7) == 0) {
                const int hb = (t >> 3) - 1;
#pragma unroll
                for (int ai = 0; ai < 2; ++ai)
#pragma unroll
                    for (int m = 0; m < 4; ++m) {
                        const float r = rat[(ai * 128 + wr * 64 + m * 16 + fr) * 4 + hb];
#pragma unroll
                        for (int bj = 0; bj < 2; ++bj)
#pragma unroll
                            for (int n = 0; n < 2; ++n) acc[ai][bj][m][n] *= r;
                    }
            }
            PG8_LDB(B0, 0, 0); PG8_LDB(B1, 0, 1); PG8_SCHED; PG8_LDA(At, 0, 0); PG8_STAGE(PG8_SA(1, 1), a1 + hstepA, voffA);
            PG8_WAIT_V(8); PG8_WAIT_L(0); PG8_BAR; PG8_MMA(0, 0, At, B0); PG8_MMA(0, 1, At, B1); PG8_BAR; PG8_SCHED;
            PG8_LDA(At, 0, 1); PG8_STAGE(PG8_SB(0, 0), b2, voffB); PG8_STAGE(PG8_SB(0, 1), b2 + hstepB, voffB); PG8_STAGE(PG8_SA(0, 0), a2, voffA);
            PG8_WAIT_V(8); PG8_WAIT_L(0); PG8_BAR; PG8_MMA(1, 0, At, B0); PG8_MMA(1, 1, At, B1); PG8_BAR; PG8_SCHED;
            PG8_LDB(B0, 1, 0); PG8_LDB(B1, 1, 1); PG8_SCHED; PG8_LDA(At, 1, 0); PG8_STAGE(PG8_SA(0, 1), a2 + hstepA, voffA);
            PG8_WAIT_V(8); PG8_WAIT_L(0); PG8_BAR; PG8_MMA(0, 0, At, B0); PG8_MMA(0, 1, At, B1); PG8_BAR; PG8_SCHED;
            PG8_LDA(At, 1, 1); PG8_STAGE(PG8_SB(1, 0), b3, voffB); PG8_STAGE(PG8_SB(1, 1), b3 + hstepB, voffB); PG8_STAGE(PG8_SA(1, 0), a3, voffA);
            PG8_WAIT_V(8); PG8_WAIT_L(0); PG8_BAR; PG8_MMA(1, 0, At, B0); PG8_MMA(1, 1, At, B1); PG8_BAR; PG8_SCHED;
        }
        if constexpr (ALIGN_EPI) { if (wr == 0) PG8_BAR; }
        E(acc, cur, wr, wc, fr, fq);
        if (!has_next) break;
#pragma unroll
        for (int a = 0; a < 2; ++a)
#pragma unroll
            for (int b = 0; b < 2; ++b)
#pragma unroll
                for (int m = 0; m < 4; ++m)
#pragma unroll
                    for (int n = 0; n < 2; ++n) acc[a][b][m][n] = (f32x4){0.f, 0.f, 0.f, 0.f};
        cur = nxt; cA = nA; cB = nB; ++ui;
        if constexpr (ALIGN_EPI) { if (wr == 1) PG8_BAR; }
    }
    PG8_WAIT_V(0);
    if constexpr (!ALIGN_EPI) { if (wr == 0) PG8_BAR; }
    PG8_BAR;
#undef PG8_SA
#undef PG8_SB
#undef PG8_STAGE
#undef PG8_LDA
#undef PG8_LDB
#undef PG8_MMA
#undef PG8_WAIT_V
#undef PG8_WAIT_L
#undef PG8_BAR
#undef PG8_SCHED
}
}

__device__ __forceinline__ float row_rs(const float* rowss, int r) {
    const GAS f32x4* rp = (const GAS f32x4*)(rowss + (size_t)r * 16);
    const f32x4 s = (rp[0] + rp[1]) + (rp[2] + rp[3]);
    return rsqrtf(((s[0] + s[1]) + (s[2] + s[3])) * (1.0f / 1024.0f) + EPS);
}

struct EpiProj {
    static constexpr bool PERM = true;
    bf16_t* PA; bf16_t* QK; const float* rowss; int lo, hi;
    __device__ __forceinline__ void operator()(const f32x4 (&acc)[2][2][4][2], const pg8::Unit& u, int wr, int wc, int fr, int fq) const {
        bf16_t* base; int ld, colt;
        if (u.pn >= lo && u.pn < hi) { base = PA; ld = LDP; colt = (u.pn - lo) * 256; }
        else { base = QK; ld = 1280; colt = (u.pn < lo ? u.pn : u.pn - (hi - lo)) * 256; }
        const int row0 = u.pm * 256 + wr * 64 + fr, col0 = colt + wc * 32 + 8 * fq;
#pragma unroll
        for (int ai = 0; ai < 2; ++ai)
#pragma unroll
            for (int m = 0; m < 4; ++m) {
                const int r = row0 + ai * 128 + m * 16;
                const float rs = row_rs(rowss, r);
                bf16_t* rowp = base + (size_t)r * ld + col0;
#pragma unroll
                for (int bj = 0; bj < 2; ++bj) {
                    const f32x4 v0 = acc[ai][bj][m][0] * rs, v1 = acc[ai][bj][m][1] * rs;
                    u32x4 w; w.x = cvt_pk_bf16(v0[0], v0[1]); w.y = cvt_pk_bf16(v0[2], v0[3]); w.z = cvt_pk_bf16(v1[0], v1[1]); w.w = cvt_pk_bf16(v1[2], v1[3]);
                    *(GAS u32x4*)(rowp + bj * 128) = w;
                }
            }
    }
};

struct EpiOut {
    static constexpr bool PERM = true;
    const float* base; float* out; bf16_t* xb; float* rowss; const LAS float* rat; bool hs; bool wxb;
    __device__ __forceinline__ void operator()(const f32x4 (&acc)[2][2][4][2], const pg8::Unit& u, int wr, int wc, int fr, int fq) const {
        const int row0 = u.pm * 256 + wr * 64 + fr, col0 = u.pn * 256 + wc * 32 + 8 * fq;
#pragma unroll
        for (int ai = 0; ai < 2; ++ai)
#pragma unroll
            for (int m = 0; m < 4; ++m) {
                const int r = row0 + ai * 128 + m * 16;
                const size_t off = (size_t)r * 1024 + col0;
                const float sc = hs ? rat[(ai * 128 + wr * 64 + m * 16 + fr) * 4 + 3] : 1.0f;
                float ss = 0.f;
#pragma unroll
                for (int bj = 0; bj < 2; ++bj) {
                    const f32x4 b0 = *(const GAS f32x4*)(base + off + bj * 128), b1 = *(const GAS f32x4*)(base + off + bj * 128 + 4);
                    const f32x4 o0 = b0 + acc[ai][bj][m][0] * sc, o1 = b1 + acc[ai][bj][m][1] * sc;
                    *(GAS f32x4*)(out + off + bj * 128) = o0; *(GAS f32x4*)(out + off + bj * 128 + 4) = o1;
                    ss += ((o0[0] * o0[0] + o0[1] * o0[1]) + (o0[2] * o0[2] + o0[3] * o0[3])) + ((o1[0] * o1[0] + o1[1] * o1[1]) + (o1[2] * o1[2] + o1[3] * o1[3]));
                    if (wxb) *(GAS u32x4*)(xb + off + bj * 128) = (u32x4){cvt_pk_bf16(o0[0], o0[1]), cvt_pk_bf16(o0[2], o0[3]), cvt_pk_bf16(o1[0], o1[1]), cvt_pk_bf16(o1[2], o1[3])};
                }
                ss += __shfl_xor(ss, 16); ss += __shfl_xor(ss, 32);
                if (fq == 0) rowss[(size_t)r * 16 + u.pn * 4 + wc] = ss;
            }
    }
};

struct EpiGlu {
    static constexpr bool PERM = true;
    bf16_t* PA; const float* bias;
    __device__ __forceinline__ void operator()(const f32x4 (&acc)[2][2][4][2], const pg8::Unit& u, int wr, int wc, int fr, int fq) const {
        const int row0 = u.pm * 256 + wr * 64 + fr, col0 = u.pn * 256 + wc * 32 + 8 * fq;
        f32x4 bv[2][2];
#pragma unroll
        for (int bj = 0; bj < 2; ++bj)
#pragma unroll
            for (int n = 0; n < 2; ++n) bv[bj][n] = *(const GAS f32x4*)(bias + col0 + bj * 128 + 4 * n);
#pragma unroll
        for (int ai = 0; ai < 2; ++ai)
#pragma unroll
            for (int m = 0; m < 4; ++m) {
                const int r = row0 + ai * 128 + m * 16;
                bf16_t* rowp = PA + (size_t)r * LDP + col0;
#pragma unroll
                for (int bj = 0; bj < 2; ++bj) {
                    const u32x4 yv = *(const GAS u32x4*)(rowp + bj * 128);
                    const u32x4 zv = *(const GAS u32x4*)(rowp + 2048 + bj * 128);
                    const f32x4 s0 = acc[ai][bj][m][0] + bv[bj][0], s1 = acc[ai][bj][m][1] + bv[bj][1];
                    float o[8];
                    const unsigned yw[4] = {yv.x, yv.y, yv.z, yv.w}, zw[4] = {zv.x, zv.y, zv.z, zv.w};
#pragma unroll
                    for (int k = 0; k < 4; ++k) {
                        const float sa = (k < 2) ? s0[2 * k] : s1[2 * k - 4], sb = (k < 2) ? s0[2 * k + 1] : s1[2 * k - 3];
                        const float ya = bflo(yw[k]), yb = bfhi(yw[k]), za = bflo(zw[k]), zb = bfhi(zw[k]);
                        o[2 * k] = ya * sigmoidf_(sa) * (za * sigmoidf_(za));
                        o[2 * k + 1] = yb * sigmoidf_(sb) * (zb * sigmoidf_(zb));
                    }
                    u32x4 w; w.x = cvt_pk_bf16(o[0], o[1]); w.y = cvt_pk_bf16(o[2], o[3]); w.z = cvt_pk_bf16(o[4], o[5]); w.w = cvt_pk_bf16(o[6], o[7]);
                    *(GAS u32x4*)(rowp + 2048 + bj * 128) = w;
                }
            }
    }
};

__device__ __attribute__((noinline)) void convert_wt(LAS unsigned char* lds, const float* W, const float* gain, bf16_t* Wt, int K, int N, int Npad, int wg, int nwg) {
    const int wave = threadIdx.x >> 6, lane = threadIdx.x & 63;
    const int tilesK = K / 16, tilesN = Npad / 64;
    for (int t = wg * 8 + wave; t < tilesK * tilesN; t += nwg * 8) {
        const int k0 = (t % tilesK) * 16, n = (t / tilesK) * 64 + lane;
        const bool ok = n < N;
        const GAS float* src = (const GAS float*)W + (size_t)k0 * N + (ok ? n : 0);
        float v[16];
#pragma unroll
        for (int kk = 0; kk < 16; ++kk) v[kk] = src[(size_t)kk * N];
        if (gain) {
#pragma unroll
            for (int kk = 0; kk < 16; ++kk) v[kk] *= ((const GAS float*)gain)[k0 + kk];
        }
        if (!ok) {
#pragma unroll
            for (int kk = 0; kk < 16; ++kk) v[kk] = 0.f;
        }
        GAS u32x4* dst = (GAS u32x4*)(Wt + (size_t)n * K + k0);
#pragma unroll
        for (int q = 0; q < 2; ++q)
            dst[q] = (u32x4){cvt_pk_bf16(v[8 * q], v[8 * q + 1]), cvt_pk_bf16(v[8 * q + 2], v[8 * q + 3]), cvt_pk_bf16(v[8 * q + 4], v[8 * q + 5]), cvt_pk_bf16(v[8 * q + 6], v[8 * q + 7])};
    }
}

__device__ __attribute__((noinline)) void xprep(const float* x, bf16_t* xb, float* rowss, int wg, int nwg) {
    const int wave = threadIdx.x >> 6, lane = threadIdx.x & 63;
    for (int row = wg * 8 + wave; row < MTOK; row += nwg * 8) {
        const GAS f32x4* xr = (const GAS f32x4*)(x + (size_t)row * 1024);
        float ss = 0.f;
#pragma unroll
        for (int i = 0; i < 4; ++i) {
            const f32x4 v = xr[lane + i * 64];
            ss += (v[0] * v[0] + v[1] * v[1]) + (v[2] * v[2] + v[3] * v[3]);
            u32x2 w; w.x = cvt_pk_bf16(v[0], v[1]); w.y = cvt_pk_bf16(v[2], v[3]);
            *(GAS u32x2*)(xb + (size_t)row * 1024 + (lane + i * 64) * 4) = w;
        }
        ss = wave_sum(ss);
        if (lane < 16) ((GAS float*)rowss)[(size_t)row * 16 + lane] = (lane == 0) ? ss : 0.f;
    }
}

__device__ __attribute__((noinline)) void final_norm(float* out, const float* rowss, const float* gain, int wg, int nwg) {
    const int wave = threadIdx.x >> 6, lane = threadIdx.x & 63;
    for (int row = wg * 8 + wave; row < MTOK; row += nwg * 8) {
        const float rs = row_rs(rowss, row);
        GAS f32x4* xr = (GAS f32x4*)(out + (size_t)row * 1024);
        const GAS f32x4* gp = (const GAS f32x4*)gain;
#pragma unroll
        for (int i = 0; i < 4; ++i) { const f32x4 v = xr[lane + i * 64], g4 = gp[lane + i * 64]; xr[lane + i * 64] = v * rs * g4; }
    }
}

__device__ __attribute__((noinline)) void gla_prep(LAS unsigned char* lds, bf16_t* QK_, bf16_t* KENDT, float* DEC_, const float* wgu_  , const float* bg_  , int wg, int nwg) {
    GAS bf16_t* QK = (GAS bf16_t*)QK_; GAS float* DEC = (GAS float*)DEC_; const GAS float* wgu = (const GAS float*)wgu_; const GAS float* bg = (const GAS float*)bg_;
    const int tid = threadIdx.x, d = tid & 127, sq = tid >> 7;
    LAS float* rS = (LAS float*)lds;
    LAS float* tot = rS + 1024;
    for (int item = wg; item < 1024; item += nwg) {
        const int n = item & 31, h = (item >> 5) & 3, b = item >> 7;
        const size_t m0 = (size_t)b * SEQ + n * 64;
        bf16_t rr[2];
#pragma unroll
        for (int i = 0; i < 2; ++i) { const int idx = tid + i * 512, s = idx >> 4, j = idx & 15; rr[i] = QK[(m0 + s) * 1280 + 1024 + j]; }
        float w[16];
#pragma unroll
        for (int j = 0; j < 16; ++j) w[j] = wgu[j * 512 + h * 128 + d];
        const float bb = bg[h * 128 + d];
        bf16_t qv[16], kv[16];
        GAS bf16_t* qp = QK + (m0 + sq * 16) * 1280 + h * 128 + d;
#pragma unroll
        for (int i = 0; i < 16; ++i) { qv[i] = qp[(size_t)i * 1280]; kv[i] = qp[(size_t)i * 1280 + 512]; }
#pragma unroll
        for (int i = 0; i < 2; ++i) rS[tid + i * 512] = bf2f(rr[i]);
        __syncthreads();
        float c[16]; float run = 0.f;
#pragma unroll
        for (int i = 0; i < 16; ++i) {
            const int s = sq * 16 + i; float g = bb;
#pragma unroll
            for (int j = 0; j < 16; ++j) g += rS[s * 16 + j] * w[j];
            const float la = (fminf(g, 0.f) - __logf(1.0f + __expf(-fabsf(g)))) * (1.0f / 16.0f);
            run += la; c[i] = run;
        }
        tot[sq * 128 + d] = run;
        __syncthreads();
        float off = 0.f, blast = 0.f;
#pragma unroll
        for (int qd = 0; qd < 4; ++qd) { const float t = tot[qd * 128 + d]; blast += t; if (qd < sq) off += t; }
        unsigned ke[8];
#pragma unroll
        for (int i = 0; i < 16; i += 2) {
            float kev[2];
#pragma unroll
            for (int e = 0; e < 2; ++e) {
                const float bc = off + c[i + e];
                const float q = bf2f(qv[i + e]), k = bf2f(kv[i + e]);
                qp[(size_t)(i + e) * 1280] = f2bf(q * __expf(bc) * 0.08838834764831845f);
                qp[(size_t)(i + e) * 1280 + 512] = f2bf(k * __expf(-bc));
                kev[e] = k * __expf(blast - bc);
            }
            ke[i >> 1] = cvt_pk_bf16(kev[0], kev[1]);
        }
        GAS u32x4* kd = (GAS u32x4*)(KENDT + ((size_t)item * 128 + d) * 64 + sq * 16);
        kd[0] = (u32x4){ke[0], ke[1], ke[2], ke[3]}; kd[1] = (u32x4){ke[4], ke[5], ke[6], ke[7]};
        if (sq == 0) DEC[item * 128 + d] = __expf(blast);
        __syncthreads();
    }
}

__device__ __forceinline__ void gla_scan(LAS unsigned char* lds, bf16_t* PA_, const bf16_t* QK_, const bf16_t* KENDT_, const float* DEC_, float* SSQ_, const float* gain_  , int wg, int nwg) {
    GAS bf16_t* PA = (GAS bf16_t*)PA_; const GAS bf16_t* QK = (const GAS bf16_t*)QK_; const GAS bf16_t* KENDT = (const GAS bf16_t*)KENDT_; const GAS float* DEC = (const GAS float*)DEC_; GAS float* SSQ = (GAS float*)SSQ_;
    int tid_ = threadIdx.x; asm volatile("" : "+v"(tid_));
    const int tid = tid_, wave = __builtin_amdgcn_readfirstlane(tid >> 6), lane = tid & 63, fr = lane & 15, fq = lane >> 4;
    LAS bf16_t* Qs = (LAS bf16_t*)lds;
    LAS bf16_t* Ks = (LAS bf16_t*)(lds + 17408);
    LAS bf16_t* KEs = (LAS bf16_t*)(lds + 34816);
    LAS bf16_t* Vt = (LAS bf16_t*)(lds + 53248);
    LAS bf16_t* As = (LAS bf16_t*)(lds + 62464);
    LAS bf16_t* St = (LAS bf16_t*)(lds + 71680);
    LAS float* decs = (LAS float*)(lds + 89088);
    LAS bf16_t* Zs = (LAS bf16_t*)(lds + 89600);
    for (int item = wg; item < 256; item += nwg) {
        const int xq_ = item & 7, iq_ = item >> 3, bh_ = xq_ * 4 + (iq_ >> 3);
        const int vs = iq_ & 7, h = bh_ & 3, b = bh_ >> 2;
        f32x4 S[4];
#pragma unroll
        for (int te = 0; te < 4; ++te) S[te] = (f32x4){0.f, 0.f, 0.f, 0.f};
        for (int i = tid; i < 64 * 136 / 2; i += 512) ((LAS unsigned*)St)[i] = 0u;
        __syncthreads();
        float gq[2][4];
#pragma unroll
        for (int q = 0; q < 2; ++q)
#pragma unroll
            for (int jj = 0; jj < 4; ++jj) gq[q][jj] = ((const GAS float*)gain_)[vs * 64 + (wave & 1) * 32 + 8 * fq + 4 * q + jj];
        struct ScanRegs { u32x4 q[2], k[2], e[2], v, z; float d; };
        ScanRegs RA, RB; RA.d = 0.f; RB.d = 0.f;
#define SCAN_LOAD(R, nn) do { const int chunk_ = (b * 4 + h) * 32 + (nn); const size_t m0_ = (size_t)b * SEQ + (nn) * 64; \
            _Pragma("unroll") for (int i = 0; i < 2; ++i) { const int p = tid + i * 512, row = p >> 4, c8 = p & 15; \
                const GAS bf16_t* src = QK + (m0_ + row) * 1280 + h * 128 + c8 * 8; \
                R.q[i] = *(const GAS u32x4*)src; R.k[i] = *(const GAS u32x4*)(src + 512); \
                const int row2 = p >> 3, c82 = p & 7; R.e[i] = *(const GAS u32x4*)(KENDT + ((size_t)chunk_ * 128 + row2) * 64 + c82 * 8); } \
            { const int s = tid >> 3, c8 = tid & 7; const GAS bf16_t* vp = PA + (m0_ + s) * LDP + h * 512 + vs * 64 + c8 * 8; R.v = *(const GAS u32x4*)vp; R.z = *(const GAS u32x4*)(vp + 2048); } \
            if (tid < 128) R.d = DEC[chunk_ * 128 + tid]; } while (0)
#define SCAN_BODY(R, nn) do { \
            const size_t m0 = (size_t)b * SEQ + (nn) * 64; \
_Pragma("unroll") \
            for (int i = 0; i < 2; ++i) { \
                const int p = tid + i * 512, row = p >> 4, c8 = p & 15; \
                *(LAS u32x4*)(Qs + row * 136 + c8 * 8) = R.q[i]; \
                *(LAS u32x4*)(Ks + row * 136 + c8 * 8) = R.k[i]; \
                const int row2 = p >> 3, c82 = p & 7; \
                *(LAS u32x4*)(KEs + row2 * 72 + c82 * 8) = R.e[i]; \
            } \
            { \
                const int s = tid >> 3, c8 = tid & 7; \
                const unsigned vw[4] = {R.v.x, R.v.y, R.v.z, R.v.w}; \
_Pragma("unroll") \
                for (int k = 0; k < 4; ++k) { Vt[(c8 * 8 + 2 * k) * 72 + s] = (bf16_t)(vw[k] & 0xffffu); Vt[(c8 * 8 + 2 * k + 1) * 72 + s] = (bf16_t)(vw[k] >> 16); } \
            } \
            { const int s = tid >> 3, c8 = tid & 7; *(LAS u32x4*)(Zs + s * 72 + c8 * 8) = R.z; } \
            if (tid < 128) decs[tid] = R.d; \
            __syncthreads(); \
            if ((nn) + 2 < 32) SCAN_LOAD(R, (nn) + 2); \
_Pragma("unroll") \
            for (int q = 0; q < 2; ++q) { \
                const int t = wave * 2 + q, tc = t >> 2, ts = t & 3; \
                f32x4 a4 = (f32x4){0.f, 0.f, 0.f, 0.f}; \
_Pragma("unroll") \
                for (int kk = 0; kk < 4; ++kk) { \
                    const bf16x8 ka = *(const LAS bf16x8*)(Ks + (ts * 16 + fr) * 136 + kk * 32 + fq * 8); \
                    const bf16x8 qb = *(const LAS bf16x8*)(Qs + (tc * 16 + fr) * 136 + kk * 32 + fq * 8); \
                    a4 = __builtin_amdgcn_mfma_f32_16x16x32_bf16(ka, qb, a4, 0, 0, 0); \
                } \
                const int c = tc * 16 + fr, s0 = ts * 16 + fq * 4; \
                float v[4]; \
_Pragma("unroll") \
                for (int j = 0; j < 4; ++j) v[j] = (s0 + j <= c) ? a4[j] : 0.f; \
                u32x2 w; w.x = cvt_pk_bf16(v[0], v[1]); w.y = cvt_pk_bf16(v[2], v[3]); \
                *(LAS u32x2*)(As + c * 72 + s0) = w; \
            } \
            __syncthreads(); \
            { \
                const int tc = wave >> 1; float ss = 0.f; unsigned ow[4]; \
_Pragma("unroll") \
                for (int q = 0; q < 2; ++q) { \
                    const int er = (wave & 1) * 32 + 8 * (fr >> 2) + 4 * q + (fr & 3); \
                    f32x4 o4 = (f32x4){0.f, 0.f, 0.f, 0.f}; \
_Pragma("unroll") \
                    for (int kk = 0; kk < 2; ++kk) { \
                        const bf16x8 va = *(const LAS bf16x8*)(Vt + er * 72 + kk * 32 + fq * 8); \
                        const bf16x8 ab = *(const LAS bf16x8*)(As + (tc * 16 + fr) * 72 + kk * 32 + fq * 8); \
                        o4 = __builtin_amdgcn_mfma_f32_16x16x32_bf16(va, ab, o4, 0, 0, 0); \
                    } \
_Pragma("unroll") \
                    for (int kk = 0; kk < 4; ++kk) { \
                        const bf16x8 sa = *(const LAS bf16x8*)(St + er * 136 + kk * 32 + fq * 8); \
                        const bf16x8 qb = *(const LAS bf16x8*)(Qs + (tc * 16 + fr) * 136 + kk * 32 + fq * 8); \
                        o4 = __builtin_amdgcn_mfma_f32_16x16x32_bf16(sa, qb, o4, 0, 0, 0); \
                    } \
                    ss += (o4[0] * o4[0] + o4[1] * o4[1]) + (o4[2] * o4[2] + o4[3] * o4[3]); \
                    const u32x2 zz = *(const LAS u32x2*)(Zs + (tc * 16 + fr) * 72 + (wave & 1) * 32 + 8 * fq + 4 * q); \
                    const float z0 = bflo(zz.x), z1 = bfhi(zz.x), z2 = bflo(zz.y), z3 = bfhi(zz.y); \
                    ow[2 * q] = cvt_pk_bf16(o4[0] * gq[q][0] * (z0 * sigmoidf_(z0)), o4[1] * gq[q][1] * (z1 * sigmoidf_(z1))); \
                    ow[2 * q + 1] = cvt_pk_bf16(o4[2] * gq[q][2] * (z2 * sigmoidf_(z2)), o4[3] * gq[q][3] * (z3 * sigmoidf_(z3))); \
                } \
                *(GAS u32x4*)(PA + (m0 + tc * 16 + fr) * LDP + h * 512 + vs * 64 + (wave & 1) * 32 + 8 * fq) = (u32x4){ow[0], ow[1], ow[2], ow[3]}; \
                ss += __shfl_xor(ss, 16); ss += __shfl_xor(ss, 32); \
                if (fq == 0) SSQ[((m0 + tc * 16 + fr) * 4 + h) * 16 + vs * 2 + (wave & 1)] = ss; \
            } \
            { \
                const f32x4 dv = *(const LAS f32x4*)(decs + wave * 16 + fq * 4); \
_Pragma("unroll") \
                for (int te = 0; te < 4; ++te) { \
                    S[te] = S[te] * dv; \
_Pragma("unroll") \
                    for (int kk = 0; kk < 2; ++kk) { \
                        const bf16x8 ka = *(const LAS bf16x8*)(KEs + (wave * 16 + fr) * 72 + kk * 32 + fq * 8); \
                        const bf16x8 vb = *(const LAS bf16x8*)(Vt + (te * 16 + fr) * 72 + kk * 32 + fq * 8); \
                        S[te] = __builtin_amdgcn_mfma_f32_16x16x32_bf16(ka, vb, S[te], 0, 0, 0); \
                    } \
                } \
            } \
            __syncthreads(); \
_Pragma("unroll") \
            for (int te = 0; te < 4; ++te) { \
                u32x2 w; w.x = cvt_pk_bf16(S[te][0], S[te][1]); w.y = cvt_pk_bf16(S[te][2], S[te][3]); \
                *(LAS u32x2*)(St + (te * 16 + fr) * 136 + wave * 16 + fq * 4) = w; \
            } \
        } while (0)
        SCAN_LOAD(RA, 0); SCAN_LOAD(RB, 1);
        for (int n = 0; n < 32; n += 2) {
            SCAN_BODY(RA, n);
            SCAN_BODY(RB, n + 1);
        }
        __syncthreads();
    }
}

__device__ __attribute__((noinline)) void gla_gate(bf16_t* PA_, const float* SSQ_, const float* gain_  , int wg, int nwg) {
    GAS bf16_t* PA = (GAS bf16_t*)PA_; const GAS float* SSQ = (const GAS float*)SSQ_; const GAS float* gain = (const GAS float*)gain_;
    const size_t total = (size_t)MTOK * 256, stride = (size_t)nwg * 512;
    for (size_t p0 = (size_t)wg * 512 + threadIdx.x; p0 < total; p0 += 2 * stride) {
        u32x4 ov[2], zv[2]; f32x4 sv[2]; GAS bf16_t* op[2]; int ee[2];
#pragma unroll
        for (int u = 0; u < 2; ++u) {
            const size_t p = p0 + u * stride; const bool ok = p < total; const size_t pp = ok ? p : p0;
            const size_t m = pp >> 8; const int col = (int)(pp & 255) * 8, h = col >> 9; ee[u] = col & 511;
            const GAS f32x4* sp = (const GAS f32x4*)(SSQ + (m * 4 + h) * 16);
            sv[u] = (sp[0] + sp[1]) + (sp[2] + sp[3]);
            op[u] = ok ? PA + m * LDP + col : nullptr;
            ov[u] = *(const GAS u32x4*)(PA + m * LDP + col); zv[u] = *(const GAS u32x4*)(PA + m * LDP + col + 2048);
        }
#pragma unroll
        for (int u = 0; u < 2; ++u) {
            const f32x4 s = sv[u];
            const float rs = rsqrtf(((s[0] + s[1]) + (s[2] + s[3])) * (1.0f / 512.0f) + EPS);
            const f32x4 g0 = *(const GAS f32x4*)(gain + ee[u]), g1 = *(const GAS f32x4*)(gain + ee[u] + 4);
            const unsigned ow[4] = {ov[u].x, ov[u].y, ov[u].z, ov[u].w}, zw[4] = {zv[u].x, zv[u].y, zv[u].z, zv[u].w};
            const float gg[8] = {g0[0], g0[1], g0[2], g0[3], g1[0], g1[1], g1[2], g1[3]};
            unsigned r[4];
#pragma unroll
            for (int k = 0; k < 4; ++k) {
                const float oa = bflo(ow[k]), ob = bfhi(ow[k]), za = bflo(zw[k]), zb = bfhi(zw[k]);
                r[k] = cvt_pk_bf16(oa * rs * gg[2 * k] * (za * sigmoidf_(za)), ob * rs * gg[2 * k + 1] * (zb * sigmoidf_(zb)));
            }
            if (op[u]) *(u32x4*)op[u] = (u32x4){r[0], r[1], r[2], r[3]};
        }
    }
}

__device__ __forceinline__ float gelu_tanh(float y) { return y * sigmoidf_(1.5957691216057308f * (y + 0.044715f * y * y * y)); }

__device__ __attribute__((noinline)) void s5_tables(LAS unsigned char* lds, bf16_t* BtY, bf16_t* BtF, float* L16, const float* lam_re_, const float* lam_im_, const float* log_dt_,
                                                    const float* b_re_, const float* b_im_, const float* c_re_, const float* c_im_, const float* dsk_, int wg, int nwg) {
    const GAS float* lam_re = (const GAS float*)lam_re_; const GAS float* lam_im = (const GAS float*)lam_im_; const GAS float* log_dt = (const GAS float*)log_dt_;
    const GAS float* b_re = (const GAS float*)b_re_; const GAS float* b_im = (const GAS float*)b_im_; const GAS float* c_re = (const GAS float*)c_re_; const GAS float* c_im = (const GAS float*)c_im_; const GAS float* dsk = (const GAS float*)dsk_;
    const int tid = threadIdx.x;
    LAS float* Bb = (LAS float*)lds;
    LAS float* Cc = Bb + 2048;
    LAS float* Pw = Cc + 2048;
    LAS float* Kl = Pw + 2176;
    for (int item = wg; item < 256; item += nwg) {
        const int g = item >> 1, half = item & 1;
        const float dt = expf(log_dt[g]);
        for (int idx = tid; idx < 17 * 64; idx += 512) {
            const int d = idx >> 6, p = idx & 63;
            const float lr = lam_re[g * 64 + p], li = lam_im[g * 64 + p];
            const float mag = expf((float)d * lr * dt), ang = (float)d * (li * dt);
            Pw[idx * 2] = mag * cosf(ang); Pw[idx * 2 + 1] = mag * sinf(ang);
        }
        for (int idx = tid; idx < 1024; idx += 512) {
            const int p = idx >> 4, jj = idx & 15;
            const float lr = lam_re[g * 64 + p], li = lam_im[g * 64 + p];
            const float mag = expf(lr * dt), ang = li * dt, lbr = mag * cosf(ang), lbi = mag * sinf(ang);
            const float nr = lbr - 1.0f, ni = lbi, den = lr * lr + li * li;
            const float bcr = (nr * lr + ni * li) / den, bci = (ni * lr - nr * li) / den;
            const float xr = b_re[(size_t)(g * 64 + p) * 16 + jj], xi = b_im[(size_t)(g * 64 + p) * 16 + jj];
            Bb[idx * 2] = bcr * xr - bci * xi; Bb[idx * 2 + 1] = bcr * xi + bci * xr;
            const int i = idx >> 6, pp = idx & 63;
            Cc[idx * 2] = c_re[(size_t)(g * 16 + i) * 64 + pp]; Cc[idx * 2 + 1] = c_im[(size_t)(g * 16 + i) * 64 + pp];
        }
        __syncthreads();
        if (half == 0 && tid < 128) ((GAS float*)L16)[g * 128 + tid] = Pw[16 * 128 + tid];
        {
            const int ij = tid & 255, i = ij >> 4, jj = ij & 15, dh = tid >> 8;
            float acc[8];
#pragma unroll
            for (int e = 0; e < 8; ++e) acc[e] = 0.f;
            for (int p = 0; p < 64; ++p) {
                const float cr = Cc[(i * 64 + p) * 2], ci = Cc[(i * 64 + p) * 2 + 1], br = Bb[(p * 16 + jj) * 2], bi = Bb[(p * 16 + jj) * 2 + 1];
                const float u = cr * br - ci * bi, v = ci * br + cr * bi;
#pragma unroll
                for (int e = 0; e < 8; ++e) { const int d = dh + 2 * e; acc[e] += Pw[(d * 64 + p) * 2] * u - Pw[(d * 64 + p) * 2 + 1] * v; }
            }
#pragma unroll
            for (int e = 0; e < 8; ++e) Kl[(dh + 2 * e) * 256 + ij] = acc[e];
        }
        __syncthreads();
        for (int idx = tid; idx < 128 * 128; idx += 512) {
            const int rl = idx >> 7, kp = idx & 127, t = half * 8 + (rl >> 4), i = rl & 15, k = 2 * kp, s = k >> 4, jj = k & 15;
            float v0 = 0.f, v1 = 0.f;
            if (s <= t) { v0 = Kl[(t - s) * 256 + i * 16 + jj]; v1 = Kl[(t - s) * 256 + i * 16 + jj + 1];
                if (s == t) { if (i == jj) v0 += dsk[g * 16 + i]; if (i == jj + 1) v1 += dsk[g * 16 + i]; } }
            *(GAS unsigned*)(BtY + ((size_t)g * 256 + t * 16 + i) * 384 + k) = cvt_pk_bf16(v0, v1);
        }
        for (int idx = tid; idx < 128 * 64; idx += 512) {
            const int rl = idx >> 6, kp = idx & 63, t = half * 8 + (rl >> 4), i = rl & 15, k2 = 2 * kp, part = k2 >> 6, p = k2 & 63;
            float v[2];
#pragma unroll
            for (int e = 0; e < 2; ++e) {
                const float cr = Cc[(i * 64 + p + e) * 2], ci = Cc[(i * 64 + p + e) * 2 + 1], pr = Pw[((t + 1) * 64 + p + e) * 2], pi = Pw[((t + 1) * 64 + p + e) * 2 + 1];
                v[e] = part == 0 ? (cr * pr - ci * pi) : -(cr * pi + ci * pr);
            }
            *(GAS unsigned*)(BtY + ((size_t)g * 256 + t * 16 + i) * 384 + 256 + k2) = cvt_pk_bf16(v[0], v[1]);
        }
        for (int idx = tid; idx < 64 * 128; idx += 512) {
            const int p = idx >> 7, kp = idx & 127, k = 2 * kp, s = k >> 4, jj = k & 15;
            const float pr = Pw[((15 - s) * 64 + p) * 2], pi = Pw[((15 - s) * 64 + p) * 2 + 1];
            float v[2];
#pragma unroll
            for (int e = 0; e < 2; ++e) { const float br = Bb[(p * 16 + jj + e) * 2], bi = Bb[(p * 16 + jj + e) * 2 + 1]; v[e] = half == 0 ? (pr * br - pi * bi) : (pr * bi + pi * br); }
            *(GAS unsigned*)(BtF + ((size_t)g * 128 + half * 64 + p) * 256 + k) = cvt_pk_bf16(v[0], v[1]);
        }
        __syncthreads();
    }
}

__device__ __attribute__((noinline)) void s5_ssm(LAS unsigned char* lds, bf16_t* PA_, const bf16_t* BtY_, const bf16_t* BtF_, const float* L16_, int wg, int nwg) {
    GAS bf16_t* PA = (GAS bf16_t*)PA_; const GAS bf16_t* BtY = (const GAS bf16_t*)BtY_; const GAS bf16_t* BtF = (const GAS bf16_t*)BtF_;
    const GAS float* L16 = (const GAS float*)L16_;
    const int tid = threadIdx.x, wave = __builtin_amdgcn_readfirstlane(tid >> 6), lane = tid & 63, fr = lane & 15, fq = lane >> 4;
    LAS bf16_t* Us = (LAS bf16_t*)lds;
    LAS bf16_t* Fs = (LAS bf16_t*)(lds + 67584);
    for (int item = wg * 4; item < 1024; item += nwg * 4)
#pragma unroll 1
    for (int sub = 0; sub < 4; ++sub) {
        const int b = (item >> 2) & 7, g = (item >> 5) * 4 + sub;
#pragma unroll
        for (int hb = 0; hb < 2; ++hb) {
            u32x4 uv[4];
#pragma unroll
            for (int r = 0; r < 4; ++r) { const int q = tid + (hb * 4 + r) * 512, tl = q >> 1, hf = q & 1; uv[r] = *(const GAS u32x4*)(PA + ((size_t)b * SEQ + tl) * LDP + g * 16 + hf * 8); }
#pragma unroll
            for (int r = 0; r < 4; ++r) { const int q = tid + (hb * 4 + r) * 512, tl = q >> 1, hf = q & 1, c = tl >> 4, s = tl & 15; *(LAS u32x4*)(Us + c * 264 + s * 16 + hf * 8) = uv[r]; }
        }
        bf16x8 bf[8];
#pragma unroll
        for (int kk = 0; kk < 8; ++kk) bf[kk] = *(const GAS bf16x8*)(BtF + ((size_t)g * 128 + wave * 16 + fr) * 256 + kk * 32 + fq * 8);
        __syncthreads();
#pragma unroll 2
        for (int mt = 0; mt < 8; ++mt) {
            f32x4 a4 = (f32x4){0.f, 0.f, 0.f, 0.f};
#pragma unroll
            for (int kk = 0; kk < 8; ++kk) {
                const bf16x8 ua = *(const LAS bf16x8*)(Us + (mt * 16 + fr) * 264 + kk * 32 + fq * 8);
                a4 = __builtin_amdgcn_mfma_f32_16x16x32_bf16(bf[kk], ua, a4, 0, 0, 0);
            }
            u32x2 w; w.x = cvt_pk_bf16(a4[0], a4[1]); w.y = cvt_pk_bf16(a4[2], a4[3]);
            *(LAS u32x2*)(Fs + (mt * 16 + fr) * 136 + wave * 16 + fq * 4) = w;
        }
        __syncthreads();
        if (tid < 64) {
            const int p = tid;
            const float l16r = L16[g * 128 + 2 * p], l16i = L16[g * 128 + 2 * p + 1];
            float sr = 0.f, si = 0.f;
            for (int c0 = 0; c0 < 128; c0 += 8) {
                float fre[8], fim[8];
#pragma unroll
                for (int e = 0; e < 8; ++e) { fre[e] = bf2f(Fs[(c0 + e) * 136 + p]); fim[e] = bf2f(Fs[(c0 + e) * 136 + 64 + p]); }
#pragma unroll
                for (int e = 0; e < 8; ++e) {
                    Fs[(c0 + e) * 136 + p] = f2bf(sr); Fs[(c0 + e) * 136 + 64 + p] = f2bf(si);
                    const float nsr = l16r * sr - l16i * si + fre[e], nsi = l16r * si + l16i * sr + fim[e];
                    sr = nsr; si = nsi;
                }
            }
        }
        __syncthreads();
#pragma unroll 1
        for (int q = 0; q < 2; ++q) {
            const int t = q == 0 ? wave : 15 - wave, nks = (t >> 1) + 1;
            const GAS bf16_t* brow = BtY + ((size_t)g * 256 + t * 16 + fr) * 384 + fq * 8;
            bf16x8 b0[4], bs[4], b1[4];
#pragma unroll
            for (int kk = 0; kk < 4; ++kk) bs[kk] = *(const GAS bf16x8*)(brow + 256 + kk * 32);
#pragma unroll
            for (int kk = 0; kk < 4; ++kk) b0[kk] = *(const GAS bf16x8*)(brow + kk * 32);
#pragma unroll
            for (int kk = 0; kk < 4; ++kk) b1[kk] = *(const GAS bf16x8*)(brow + (4 + kk) * 32);
#pragma unroll 1
            for (int mh = 0; mh < 2; ++mh) {
                f32x4 acc[4];
#pragma unroll
                for (int m = 0; m < 4; ++m) acc[m] = (f32x4){0.f, 0.f, 0.f, 0.f};
                const LAS bf16_t* fsb = Fs + (mh * 64 + fr) * 136 + fq * 8;
                const LAS bf16_t* usb = Us + (mh * 64 + fr) * 264 + fq * 8;
#pragma unroll
                for (int kk = 0; kk < 4; ++kk) {
#pragma unroll
                    for (int m = 0; m < 4; ++m) {
                        const bf16x8 ua = *(const LAS bf16x8*)(fsb + m * 16 * 136 + kk * 32);
                        acc[m] = __builtin_amdgcn_mfma_f32_16x16x32_bf16(bs[kk], ua, acc[m], 0, 0, 0);
                    }
                }
#pragma unroll
                for (int kk = 0; kk < 4; ++kk) {
                    if (kk < nks) {
#pragma unroll
                        for (int m = 0; m < 4; ++m) {
                            const bf16x8 ua = *(const LAS bf16x8*)(usb + m * 16 * 264 + kk * 32);
                            acc[m] = __builtin_amdgcn_mfma_f32_16x16x32_bf16(b0[kk], ua, acc[m], 0, 0, 0);
                        }
                    }
                }
#pragma unroll
                for (int kk = 0; kk < 4; ++kk) {
                    if (4 + kk < nks) {
#pragma unroll
                        for (int m = 0; m < 4; ++m) {
                            const bf16x8 ua = *(const LAS bf16x8*)(usb + m * 16 * 264 + (4 + kk) * 32);
                            acc[m] = __builtin_amdgcn_mfma_f32_16x16x32_bf16(b1[kk], ua, acc[m], 0, 0, 0);
                        }
                    }
                }
#pragma unroll
                for (int m = 0; m < 4; ++m) {
                    const int mt = mh * 4 + m;
                    u32x2 w; w.x = cvt_pk_bf16(gelu_tanh(acc[m][0]), gelu_tanh(acc[m][1])); w.y = cvt_pk_bf16(gelu_tanh(acc[m][2]), gelu_tanh(acc[m][3]));
                    *(GAS u32x2*)(PA + ((size_t)b * SEQ + (mt * 16 + fr) * 16 + t) * LDP + g * 16 + fq * 4) = w;
                }
            }
        }
        __syncthreads();
    }
}


__device__ __attribute__((noinline)) void gla_rat(LAS unsigned char* lds, const float* SSQ_, int pm) {
    const GAS float* SSQ = (const GAS float*)SSQ_;
    LAS float* rt = (LAS float*)(lds + RAT_OFF);
    for (int idx = threadIdx.x; idx < 1024; idx += 512) {
        const int row = idx >> 2, hh = idx & 3;
        const GAS f32x4* sp = (const GAS f32x4*)(SSQ + ((size_t)(pm * 256 + row) * 4 + hh) * 16);
        const f32x4 s4 = (sp[0] + sp[1]) + (sp[2] + sp[3]);
        rt[idx] = rsqrtf(((s4[0] + s4[1]) + (s4[2] + s4[3])) * (1.0f / 512.0f) + EPS);
    }
    __syncthreads();
    if (threadIdx.x < 256) { const int row = threadIdx.x; const float r0 = rt[row * 4], r1 = rt[row * 4 + 1], r2 = rt[row * 4 + 2], r3 = rt[row * 4 + 3];
        rt[row * 4] = r0 / r1; rt[row * 4 + 1] = r1 / r2; rt[row * 4 + 2] = r2 / r3; rt[row * 4 + 3] = r3; }
    __syncthreads();
}

struct Params { const float* in[21]; float* out; unsigned char* ws; };

__global__ void __launch_bounds__(512, 2) fwd_megakernel(Params P) {
    extern __shared__ __attribute__((aligned(16))) unsigned char lds_raw[];
    LAS unsigned char* lds = (LAS unsigned char*)lds_raw;
    cg::grid_group grid = cg::this_grid();
    volatile LAS unsigned* xst = (volatile LAS unsigned*)(lds + 131072);
    if (threadIdx.x < 4) xst[threadIdx.x] = 0u;
    __syncthreads();
    unsigned* barw = (unsigned*)(P.ws + WS_BAR);
    const XcdBarrier xb = xcd_barrier_post(barw, xst);
#define GSYNC() xcd_barrier(xb.bar, xb.x, xb.st)
#ifdef PROBE_CLASS
    unsigned long long pt0 = __builtin_amdgcn_s_memrealtime(), pacc = 0ull;
#define STAMP(cls) do { const unsigned long long _t = __builtin_amdgcn_s_memrealtime(); if ((cls) == PROBE_CLASS) pacc += _t - pt0; pt0 = _t; } while (0)
#else
#define STAMP(cls) do {} while (0)
#endif
    const int wg = blockIdx.x, nwg = gridDim.x;
    unsigned char* ws = P.ws;
    bf16_t* WGLA_IN = (bf16_t*)(ws + WS_WGLA_IN); bf16_t* WGLA_OUT = (bf16_t*)(ws + WS_WGLA_OUT);
    bf16_t* WS5_IN = (bf16_t*)(ws + WS_WS5_IN); bf16_t* WS5_GLU = (bf16_t*)(ws + WS_WS5_GLU); bf16_t* WS5_OUT = (bf16_t*)(ws + WS_WS5_OUT);
    bf16_t* XB = (bf16_t*)(ws + WS_XB); bf16_t* KENDT = XB;
    bf16_t* PA = (bf16_t*)(ws + WS_PA); bf16_t* QK = (bf16_t*)(ws + WS_QK);
    bf16_t* BTY = (bf16_t*)(ws + WS_BTY); bf16_t* BTF = (bf16_t*)(ws + WS_BTF);
    float* RSS = (float*)(ws + WS_RSS); float* DEC = (float*)(ws + WS_DEC); float* SSQ = (float*)(ws + WS_SSQ);
    const float* x = P.in[0];
    float* out = P.out;

    convert_wt(lds, P.in[2], P.in[1], WGLA_IN, 1024, GLA_IN, GLA_NP, wg, nwg);
    convert_wt(lds, P.in[6], nullptr, WGLA_OUT, 2048, 1024, 1024, wg, nwg);
    convert_wt(lds, P.in[8], P.in[7], WS5_IN, 1024, 4096, 4096, wg, nwg);
    convert_wt(lds, P.in[17], nullptr, WS5_GLU, 2048, 2048, 2048, wg, nwg);
    convert_wt(lds, P.in[19], nullptr, WS5_OUT, 2048, 1024, 1024, wg, nwg);
    xprep(x, XB, RSS, wg, nwg);
    GSYNC();
    STAMP(0);

    for (int layer = 0; layer < 4; ++layer) {
        const int j = layer >> 1;
        const bool is_s5 = (layer & 1) != 0;
        const float* resid = (layer == 0) ? x : out;
        if (is_s5)
            s5_tables(lds, BTY, BTF, (float*)(ws + WS_L16), P.in[9] + (size_t)j * 128 * 64, P.in[10] + (size_t)j * 128 * 64, P.in[11] + (size_t)j * 128,
                      P.in[12] + (size_t)j * 128 * 64 * 16, P.in[13] + (size_t)j * 128 * 64 * 16,
                      P.in[14] + (size_t)j * 128 * 16 * 64, P.in[15] + (size_t)j * 128 * 16 * 64, P.in[16] + (size_t)j * 128 * 16, wg, nwg);
        { pg8::Gemm g{XB, is_s5 ? WS5_IN : WGLA_IN, MTOK, is_s5 ? 4096 : GLA_NP, 1024, 1024}; pg8::StaticOrder S; S.init(MTOK, g.N, nwg, wg);
          EpiProj E{PA, QK, RSS, is_s5 ? 0 : 4, is_s5 ? 16 : 20}; pg8::gemm_phase<EpiProj, true>(lds, g, S, E); }
        if (layer == 2) {
            const int first = (nwg > 128) ? 64 : 0;
            if (wg >= first) {
                convert_wt(lds, P.in[8] + (size_t)1024 * 4096, P.in[7] + 1024, WS5_IN, 1024, 4096, 4096, wg - first, nwg - first);
                convert_wt(lds, P.in[17] + (size_t)2048 * 2048, nullptr, WS5_GLU, 2048, 2048, 2048, wg - first, nwg - first);
                convert_wt(lds, P.in[19] + (size_t)2048 * 1024, nullptr, WS5_OUT, 2048, 1024, 1024, wg - first, nwg - first);
            }
        }
        GSYNC();
        STAMP(1);
        if (!is_s5) {
            gla_prep(lds, QK, KENDT, DEC, P.in[3] + (size_t)j * 16 * 512, P.in[4] + (size_t)j * 512, wg, nwg);
            GSYNC();
            STAMP(2);
            gla_scan(lds, PA, QK, KENDT, DEC, SSQ, P.in[5] + (size_t)j * 512, wg, nwg);
            GSYNC();
            STAMP(3);
        } else {
            if (layer == 1) {
                convert_wt(lds, P.in[2] + (size_t)1024 * GLA_IN, P.in[1] + 1024, WGLA_IN, 1024, GLA_IN, GLA_NP, wg, nwg);
                convert_wt(lds, P.in[6] + (size_t)2048 * 1024, nullptr, WGLA_OUT, 2048, 1024, 1024, wg, nwg);
            }
            s5_ssm(lds, PA, BTY, BTF, (const float*)(ws + WS_L16), wg, nwg);
            GSYNC();
            STAMP(6);
            { pg8::Gemm g{PA, WS5_GLU, MTOK, 2048, 2048, LDP}; pg8::StaticOrder S; S.init(MTOK, 2048, nwg, wg);
              EpiGlu E{PA, P.in[18] + (size_t)j * 2048}; pg8::gemm_phase<EpiGlu, true>(lds, g, S, E); }
            GSYNC();
            STAMP(7);
        }
        { pg8::Gemm g{is_s5 ? PA + 2048 : PA, is_s5 ? WS5_OUT : WGLA_OUT, MTOK, 1024, 2048, LDP}; pg8::StaticOrder S; S.init(MTOK, 1024, nwg, wg);
          if (!is_s5) { pg8::Unit u0; u0.pm = 0; u0.pn = 0; S.next(0, u0); gla_rat(lds, SSQ, u0.pm); }
          EpiOut E{resid, out, XB, RSS, (const LAS float*)(lds + RAT_OFF), !is_s5, layer != 3}; pg8::gemm_phase<EpiOut, true>(lds, g, S, E, !is_s5); }
        GSYNC();
        STAMP(5);
    }
    final_norm(out, RSS, P.in[20], wg, nwg);
    if (P.ws == nullptr) grid.sync();
#ifdef PROBE_CLASS
    if (wg == 0) { const unsigned long long te = __builtin_amdgcn_s_memrealtime(); while (__builtin_amdgcn_s_memrealtime() - te < pacc) __builtin_amdgcn_s_sleep(8); }
#endif
}

extern "C" void kernel_launch(void* const* d_in, const int* in_sizes, int n_in, void* d_out, int out_size, void* d_ws, size_t ws_size, hipStream_t stream) {
    static int grid_blocks = 0;
    if (!grid_blocks) {
        int dev = 0, cus = 0, per_cu = 0;
        (void)hipGetDevice(&dev);
        (void)hipDeviceGetAttribute(&cus, hipDeviceAttributeMultiprocessorCount, dev);
        (void)hipFuncSetAttribute((const void*)fwd_megakernel, hipFuncAttributeMaxDynamicSharedMemorySize, LDS_BYTES);
        (void)hipOccupancyMaxActiveBlocksPerMultiprocessor(&per_cu, (const void*)fwd_megakernel, 512, LDS_BYTES);
        if (per_cu < 1) { fprintf(stderr, "occupancy query returned %d\n", per_cu); per_cu = 1; }
        if (per_cu > 1) per_cu = 1;
        grid_blocks = cus * per_cu;
        if (ws_size < WS_END) fprintf(stderr, "workspace too small: %zu < %zu\n", ws_size, (size_t)WS_END);
    }
    (void)hipMemsetAsync((char*)d_ws + WS_BAR, 0, 16384, stream);
    Params p{};
    for (int i = 0; i < 21; ++i) p.in[i] = (const float*)d_in[i];
    p.out = (float*)d_out; p.ws = (unsigned char*)d_ws;
    void* args[] = {&p};
    hipError_t e = hipLaunchCooperativeKernel((void*)fwd_megakernel, dim3(grid_blocks), dim3(512), args, LDS_BYTES, stream);
    if (e != hipSuccess) fprintf(stderr, "cooperative launch failed: %s (grid %d)\n", hipGetErrorString(e), grid_blocks);
}
```

```cpp
#include <hip/hip_runtime.h>
#include <hip/hip_cooperative_groups.h>
#include <cstdio>
namespace cg = cooperative_groups;

#define LAS __attribute__((address_space(3)))
#define GAS __attribute__((address_space(1)))
typedef unsigned short bf16_t;
typedef short bf16x8 __attribute__((ext_vector_type(8)));
typedef float f32x4 __attribute__((ext_vector_type(4)));
typedef float f32x2 __attribute__((ext_vector_type(2)));
typedef unsigned u32x4 __attribute__((ext_vector_type(4)));
typedef unsigned u32x2 __attribute__((ext_vector_type(2)));

constexpr int MTOK = 16384, DM = 1024, DI = 2048, SEQ = 2048;
constexpr int GLA_IN = 5136, GLA_NP = 5376;
constexpr float EPS = 1e-6f;
constexpr int LDP = 4160;
constexpr int RAT_OFF = 131072 + 64;
constexpr int LDS_BYTES = RAT_OFF + 4096;

constexpr size_t WS_WGLA_IN = 0;
constexpr size_t WS_WGLA_OUT = WS_WGLA_IN + (size_t)GLA_NP * 1024 * 2;
constexpr size_t WS_WS5_IN = WS_WGLA_OUT + (size_t)1024 * 2048 * 2;
constexpr size_t WS_WS5_GLU = WS_WS5_IN + (size_t)4096 * 1024 * 2;
constexpr size_t WS_WS5_OUT = WS_WS5_GLU + (size_t)2048 * 2048 * 2;
constexpr size_t WS_XB = WS_WS5_OUT + (size_t)1024 * 2048 * 2;
constexpr size_t WS_PA = WS_XB + (size_t)MTOK * 1024 * 2;
constexpr size_t WS_QK = WS_PA + (size_t)MTOK * LDP * 2;
constexpr size_t WS_RSS = WS_QK + (size_t)MTOK * 1280 * 2;
constexpr size_t WS_DEC = WS_RSS + (size_t)MTOK * 16 * 4;
constexpr size_t WS_SSQ = WS_DEC + (size_t)1024 * 128 * 4;
constexpr size_t WS_BAR = WS_SSQ + (size_t)MTOK * 64 * 4;
constexpr size_t WS_L16 = WS_BAR + 16384;
constexpr size_t WS_END = WS_L16 + 128 * 64 * 2 * 4;
constexpr size_t WS_BTY = WS_QK;
constexpr size_t WS_BTF = WS_BTY + (size_t)128 * 256 * 384 * 2;
static_assert(WS_BTF + (size_t)128 * 128 * 256 * 2 <= WS_RSS, "S5 tables must fit in the QK region");
static_assert(WS_END <= (size_t)256 * 1024 * 1024, "workspace budget");

__device__ __forceinline__ float bf2f(bf16_t b) { return __uint_as_float(((unsigned)b) << 16); }
__device__ __forceinline__ float bflo(unsigned w) { return __uint_as_float(w << 16); }
__device__ __forceinline__ float bfhi(unsigned w) { return __uint_as_float(w & 0xffff0000u); }
typedef __bf16 bf16x2_t __attribute__((ext_vector_type(2)));
__device__ __forceinline__ unsigned cvt_pk_bf16(float lo, float hi) { const f32x2 v = {lo, hi}; const bf16x2_t r = __builtin_convertvector(v, bf16x2_t); return __builtin_bit_cast(unsigned, r); }
__device__ __forceinline__ bf16_t f2bf(float f) { return (bf16_t)(cvt_pk_bf16(f, 0.f) & 0xffffu); }
__device__ __forceinline__ float sigmoidf_(float x) { return __builtin_amdgcn_rcpf(1.0f + __expf(-x)); }
__device__ __forceinline__ float wave_sum(float v) {
#pragma unroll
    for (int o = 32; o > 0; o >>= 1) v += __shfl_xor(v, o);
    return v;
}


#define XB_TMO      128
#define XB_XCNT(j)  (256  + 64 * (j))
#define XB_XSUB(j)  (1280 + 64 * (j))
#define XB_XGEN(j)  (2304 + 64 * (j))
#define XB_TOP      3328
#define XB_TOPGEN   3392
#define XCD_BAR_WORDS 3456
#define XB_SPIN_CAP (1u << 18)
__device__ __forceinline__ unsigned xb_ld(unsigned* p)              { return __hip_atomic_load(p, __ATOMIC_RELAXED, __HIP_MEMORY_SCOPE_AGENT); }
__device__ __forceinline__ unsigned xb_add(unsigned* p, unsigned v) { return __hip_atomic_fetch_add(p, v, __ATOMIC_RELAXED, __HIP_MEMORY_SCOPE_AGENT); }
__device__ __forceinline__ unsigned xb_xcc_id() { return (unsigned)__builtin_amdgcn_s_getreg((3 << 11) | 20) & 0xFu; }
#define XB_SPIN(cond, bar) do { unsigned _sp = 0; while (cond) { __builtin_amdgcn_s_sleep(1); \
    if ((++_sp & 255u) == 0u) { if (xb_ld(&(bar)[XB_TMO])) break; if (_sp > XB_SPIN_CAP) { atomicAdd(&(bar)[XB_TMO], 1u); break; } } } } while (0)
struct XcdBarrier { unsigned* bar; unsigned x; volatile LAS unsigned* st; };
__device__ __forceinline__ XcdBarrier xcd_barrier_post(unsigned* bar, volatile LAS unsigned* st) {
    XcdBarrier b; b.bar = bar; b.x = xb_xcc_id(); b.st = st;
    if (threadIdx.x == 0) (void)xb_add(&bar[XB_XCNT(b.x)], 1u);
    return b;
}
__device__ __forceinline__ void xcd_barrier_complete(unsigned* bar, unsigned x, unsigned& nloc, unsigned& nx) {
    const unsigned G = gridDim.x * gridDim.y * gridDim.z;
    unsigned sum, cnt, mine, sp = 0u;
    for (;;) {
        sum = 0u; cnt = 0u; mine = 0u;
#pragma unroll
        for (unsigned j = 0; j < 16; ++j) { const unsigned c = xb_ld(&bar[XB_XCNT(j)]); sum += c; cnt += (c > 0u) ? 1u : 0u; mine = (j == x) ? c : mine; }
        if (sum == G) break;
        __builtin_amdgcn_s_sleep(1);
        if ((++sp & 255u) == 0u) { if (xb_ld(&bar[XB_TMO])) break; if (sp > XB_SPIN_CAP) { atomicAdd(&bar[XB_TMO], 1u); break; } }
    }
    nloc = mine > 0u ? mine : 1u; nx = cnt > 0u ? cnt : 1u;
}
__device__ __attribute__((noinline)) void xcd_barrier(unsigned* bar, unsigned x, volatile LAS unsigned* st) {
    asm volatile("s_waitcnt vmcnt(0)" ::: "memory");
    __syncthreads();
    if (threadIdx.x == 0) {
        __builtin_amdgcn_s_waitcnt(0);
        unsigned nloc = st[0], nx = st[1];
        if (nloc == 0u) { xcd_barrier_complete(bar, x, nloc, nx); st[0] = nloc; st[1] = nx; }
        const unsigned old = xb_add(&bar[XB_XSUB(x)], 1u);
        const unsigned gen = old / nloc;
        if (old + 1u == (gen + 1u) * nloc) {
            __builtin_amdgcn_fence(__ATOMIC_RELEASE, "agent");
            asm volatile("s_waitcnt vmcnt(0)" ::: "memory");
            const unsigned og = xb_add(&bar[XB_TOP], 1u);
            const unsigned tg = og / nx;
            if (og + 1u == (tg + 1u) * nx) xb_add(&bar[XB_TOPGEN], 1u);
            else XB_SPIN(xb_ld(&bar[XB_TOPGEN]) == tg, bar);
            __builtin_amdgcn_fence(__ATOMIC_ACQUIRE, "agent");
            xb_add(&bar[XB_XGEN(x)], 1u);
            asm volatile("s_waitcnt vmcnt(0)" ::: "memory");
        } else {
            XB_SPIN(xb_ld(&bar[XB_XGEN(x)]) == gen, bar);
            __builtin_amdgcn_fence(__ATOMIC_ACQUIRE, "agent");
            asm volatile("s_waitcnt vmcnt(0)" ::: "memory");
        }
    }
    __syncthreads();
}

namespace pg8 {
constexpr int BM = 256, BK = 64, HALF = 128, HTB = HALF * BK * 2, STAGE_BYTES = 8 * HTB, NXCD = 8, WGM = 4;
__host__ __device__ __forceinline__ int lds_byte(int r, int c) { const int st = (r >> 4) * 2 + (c >> 5), rr = r & 15, cc = c & 31, ob = rr * 64 + cc * 2; return st * 1024 + (ob ^ (((ob >> 9) & 1) << 5)); }
__host__ __device__ __forceinline__ void stage_rc(int b, int& R, int& C) { const int st = b / 1024, sb = b % 1024, swz = sb ^ (((sb >> 9) & 1) << 5); R = (st >> 1) * 16 + swz / 64; C = (st & 1) * 32 + (swz % 64) / 2; }
__host__ __device__ __forceinline__ int perm32(int rho) { const int n = rho >> 4, i = rho & 15; return 8 * (i >> 2) + 4 * n + (i & 3); }

struct Unit { int pm, pn; };
struct Gemm { const bf16_t* A; const bf16_t* Bt; int M, N, K, lda; };

struct StaticOrder {
    int nM, nN, nwg, G, c;
    __host__ __device__ void init(int M, int N, int G_, int c_) { nM = M / BM; nN = N / BM; nwg = nM * nN; G = G_; c = c_; }
    __host__ __device__ bool next(int i, Unit& u) const {
        const long L = (long)i * G + c; if (L >= nwg) return false;
        int wgid = (int)L; { const int q = nwg / NXCD, r = nwg % NXCD, xcd = wgid % NXCD, off = wgid / NXCD; wgid = (xcd < r ? xcd * (q + 1) : r * (q + 1) + (xcd - r) * q) + off; }
        const int nig = WGM * nN, gid = wgid / nig, fm = gid * WGM, gsz = (nM - fm) < WGM ? (nM - fm) : WGM;
        u.pm = fm + ((wgid % nig) % gsz); u.pn = (wgid % nig) / gsz; return true;
    }
};

template <class Epi, bool ALIGN_EPI>
__device__ __forceinline__ void gemm_phase(LAS unsigned char* lds, const Gemm g, const StaticOrder& S, const Epi& E, const bool hs = false) {
    const LAS float* rat = (const LAS float*)(lds + RAT_OFF);
    int tid_ = threadIdx.x; asm volatile("" : "+v"(tid_));
    const int tid = tid_, wid = __builtin_amdgcn_readfirstlane(tid >> 6), lane = tid & 63, wr = wid >> 2, wc = wid & 3, fr = lane & 15, fq = lane >> 4;
    const int K = g.K, nt = K / BK, lda = g.lda;
    unsigned voffA, voffB;
    { int R, C; stage_rc(tid * 16, R, C); const int Rb = Epi::PERM ? ((R & ~31) + perm32(R & 31)) : R;
      voffA = (unsigned)(R * lda + C) * 2u; voffB = (unsigned)(Rb * K + C) * 2u; }
    const size_t rsvoffA = (size_t)64 * lda * 2, rsvoffB = (size_t)64 * K * 2; typedef char voffA_tag; typedef char voffB_tag;
    const size_t kstep = (size_t)(BK * 2);
    const size_t hstepA = (size_t)HALF * lda * 2, hstepB = (size_t)HALF * K * 2;
    const size_t tstepA = 2 * hstepA, tstepB = 2 * hstepB;
    const unsigned ldsw = (unsigned)wid * 1024u;
    const int aoff = lds_byte(wr * 64 + fr, fq * 8), boff = lds_byte(wc * 32 + fr, fq * 8);
#define PG8_SA(b, h) (((b) * 2 + (h)) * HTB)
#define PG8_SB(b, h) ((4 + (b) * 2 + (h)) * HTB)
#define PG8_STAGE(bufoff, gbase, voff) do { \
        __builtin_amdgcn_global_load_lds((const unsigned*)((const char*)(gbase) + (voff)), (LAS unsigned*)(lds + (bufoff) + ldsw), 16, 0, 0); \
        __builtin_amdgcn_global_load_lds((const unsigned*)((const char*)(gbase) + (sizeof(voff##_tag) ? rs##voff : 0) + (voff)), (LAS unsigned*)(lds + (bufoff) + ldsw + 8192), 16, 0, 0); } while (0)
#define PG8_LDA(dst, b, h) do { _Pragma("unroll") for (int m = 0; m < 4; ++m) _Pragma("unroll") for (int k = 0; k < 2; ++k) dst[m][k] = *(const LAS bf16x8*)(lds + PG8_SA(b, h) + aoff + m * 2048 + k * 1024); } while (0)
#define PG8_LDB(dst, b, h) do { _Pragma("unroll") for (int n = 0; n < 2; ++n) _Pragma("unroll") for (int k = 0; k < 2; ++k) dst[n][k] = *(const LAS bf16x8*)(lds + PG8_SB(b, h) + boff + n * 2048 + k * 1024); } while (0)
#define PG8_MMA(ai, bj, At, Bt) do { __builtin_amdgcn_s_setprio(1); _Pragma("unroll") for (int m = 0; m < 4; ++m) _Pragma("unroll") for (int n = 0; n < 2; ++n) _Pragma("unroll") for (int k = 0; k < 2; ++k) \
        acc[ai][bj][m][n] = __builtin_amdgcn_mfma_f32_16x16x32_bf16(Bt[n][k], At[m][k], acc[ai][bj][m][n], 0, 0, 0); __builtin_amdgcn_s_setprio(0); } while (0)
#define PG8_WAIT_V(n) asm volatile("s_waitcnt vmcnt(" #n ")" ::: "memory")
#define PG8_WAIT_L(n) asm volatile("s_waitcnt lgkmcnt(" #n ")" ::: "memory")
#define PG8_BAR __builtin_amdgcn_s_barrier()
#define PG8_SCHED __builtin_amdgcn_sched_barrier(0)
    Unit cur, nxt; int ui = 0;
    if (!S.next(0, cur)) return;
    f32x4 acc[2][2][4][2];
#pragma unroll
    for (int a = 0; a < 2; ++a)
#pragma unroll
        for (int b = 0; b < 2; ++b)
#pragma unroll
            for (int m = 0; m < 4; ++m)
#pragma unroll
                for (int n = 0; n < 2; ++n) acc[a][b][m][n] = (f32x4){0.f, 0.f, 0.f, 0.f};
    bf16x8 At[4][2], B0[2][2], B1[2][2];
    const char* cA = (const char*)g.A + (size_t)cur.pm * tstepA; const char* cB = (const char*)g.Bt + (size_t)cur.pn * tstepB;
    PG8_STAGE(PG8_SB(0, 0), cB, voffB); PG8_STAGE(PG8_SB(0, 1), cB + hstepB, voffB); PG8_STAGE(PG8_SA(0, 0), cA, voffA); PG8_STAGE(PG8_SA(0, 1), cA + hstepA, voffA);
    if (wr == 1) PG8_BAR;
    PG8_WAIT_V(2); PG8_BAR;
    PG8_STAGE(PG8_SB(1, 0), cB + kstep, voffB); PG8_STAGE(PG8_SA(1, 0), cA + kstep, voffA); PG8_STAGE(PG8_SB(1, 1), cB + hstepB + kstep, voffB);
    PG8_WAIT_V(6); PG8_BAR;
    for (;;) {
        const bool has_next = S.next(ui + 1, nxt);
        const char* nA = has_next ? (const char*)g.A + (size_t)nxt.pm * tstepA : cA; const char* nB = has_next ? (const char*)g.Bt + (size_t)nxt.pn * tstepB : cB;
        for (int t = 0; t < nt; t += 2) {
            const bool last = (t == nt - 2);
            const char* a1 = cA + (size_t)(t + 1) * kstep;
            const char* a2 = last ? nA : cA + (size_t)(t + 2) * kstep; const char* b2 = last ? nB : cB + (size_t)(t + 2) * kstep;
            const char* a3 = a2 + kstep; const char* b3 = b2 + kstep;
            if (hs && t != 0 && (t & 7) == 0) {
                const int hb = (t >> 3) - 1;
#pragma unroll
                for (int ai = 0; ai < 2; ++ai)
#pragma unroll
                    for (int m = 0; m < 4; ++m) {
                        const float r = rat[(ai * 128 + wr * 64 + m * 16 + fr) * 4 + hb];
#pragma unroll
                        for (int bj = 0; bj < 2; ++bj)
#pragma unroll
                            for (int n = 0; n < 2; ++n) acc[ai][bj][m][n] *= r;
                    }
            }
            PG8_LDB(B0, 0, 0); PG8_LDB(B1, 0, 1); PG8_SCHED; PG8_LDA(At, 0, 0); PG8_STAGE(PG8_SA(1, 1), a1 + hstepA, voffA);
            PG8_WAIT_V(8); PG8_WAIT_L(0); PG8_BAR; PG8_MMA(0, 0, At, B0); PG8_MMA(0, 1, At, B1); PG8_BAR; PG8_SCHED;
            PG8_LDA(At, 0, 1); PG8_STAGE(PG8_SB(0, 0), b2, voffB); PG8_STAGE(PG8_SB(0, 1), b2 + hstepB, voffB); PG8_STAGE(PG8_SA(0, 0), a2, voffA);
            PG8_WAIT_V(8); PG8_WAIT_L(0); PG8_BAR; PG8_MMA(1, 0, At, B0); PG8_MMA(1, 1, At, B1); PG8_BAR; PG8_SCHED;
            PG8_LDB(B0, 1, 0); PG8_LDB(B1, 1, 1); PG8_SCHED; PG8_LDA(At, 1, 0); PG8_STAGE(PG8_SA(0, 1), a2 + hstepA, voffA);
            PG8_WAIT_V(8); PG8_WAIT_L(0); PG8_BAR; PG8_MMA(0, 0, At, B0); PG8_MMA(0, 1, At, B1); PG8_BAR; PG8_SCHED;
            PG8_LDA(At, 1, 1); PG8_STAGE(PG8_SB(1, 0), b3, voffB); PG8_STAGE(PG8_SB(1, 1), b3 + hstepB, voffB); PG8_STAGE(PG8_SA(1, 0), a3, voffA);
            PG8_WAIT_V(8); PG8_WAIT_L(0); PG8_BAR; PG8_MMA(1, 0, At, B0); PG8_MMA(1, 1, At, B1); PG8_BAR; PG8_SCHED;
        }
        if constexpr (ALIGN_EPI) { if (wr == 0) PG8_BAR; }
        E(acc, cur, wr, wc, fr, fq);
        if (!has_next) break;
#pragma unroll
        for (int a = 0; a < 2; ++a)
#pragma unroll
            for (int b = 0; b < 2; ++b)
#pragma unroll
                for (int m = 0; m < 4; ++m)
#pragma unroll
                    for (int n = 0; n < 2; ++n) acc[a][b][m][n] = (f32x4){0.f, 0.f, 0.f, 0.f};
        cur = nxt; cA = nA; cB = nB; ++ui;
        if constexpr (ALIGN_EPI) { if (wr == 1) PG8_BAR; }
    }
    PG8_WAIT_V(0);
    if constexpr (!ALIGN_EPI) { if (wr == 0) PG8_BAR; }
    PG8_BAR;
#undef PG8_SA
#undef PG8_SB
#undef PG8_STAGE
#undef PG8_LDA
#undef PG8_LDB
#undef PG8_MMA
#undef PG8_WAIT_V
#undef PG8_WAIT_L
#undef PG8_BAR
#undef PG8_SCHED
}
}

__device__ __forceinline__ float row_rs(const float* rowss, int r) {
    const GAS f32x4* rp = (const GAS f32x4*)(rowss + (size_t)r * 16);
    const f32x4 s = (rp[0] + rp[1]) + (rp[2] + rp[3]);
    return rsqrtf(((s[0] + s[1]) + (s[2] + s[3])) * (1.0f / 1024.0f) + EPS);
}

struct EpiProj {
    static constexpr bool PERM = true;
    bf16_t* PA; bf16_t* QK; const float* rowss; int lo, hi;
    __device__ __forceinline__ void operator()(const f32x4 (&acc)[2][2][4][2], const pg8::Unit& u, int wr, int wc, int fr, int fq) const {
        bf16_t* base; int ld, colt;
        if (u.pn >= lo && u.pn < hi) { base = PA; ld = LDP; colt = (u.pn - lo) * 256; }
        else { base = QK; ld = 1280; colt = (u.pn < lo ? u.pn : u.pn - (hi - lo)) * 256; }
        const int row0 = u.pm * 256 + wr * 64 + fr, col0 = colt + wc * 32 + 8 * fq;
#pragma unroll
        for (int ai = 0; ai < 2; ++ai)
#pragma unroll
            for (int m = 0; m < 4; ++m) {
                const int r = row0 + ai * 128 + m * 16;
                const float rs = row_rs(rowss, r);
                bf16_t* rowp = base + (size_t)r * ld + col0;
#pragma unroll
                for (int bj = 0; bj < 2; ++bj) {
                    const f32x4 v0 = acc[ai][bj][m][0] * rs, v1 = acc[ai][bj][m][1] * rs;
                    u32x4 w; w.x = cvt_pk_bf16(v0[0], v0[1]); w.y = cvt_pk_bf16(v0[2], v0[3]); w.z = cvt_pk_bf16(v1[0], v1[1]); w.w = cvt_pk_bf16(v1[2], v1[3]);
                    *(GAS u32x4*)(rowp + bj * 128) = w;
                }
            }
    }
};

struct EpiOut {
    static constexpr bool PERM = true;
    const float* base; float* out; bf16_t* xb; float* rowss; const LAS float* rat; bool hs; bool wxb;
    __device__ __forceinline__ void operator()(const f32x4 (&acc)[2][2][4][2], const pg8::Unit& u, int wr, int wc, int fr, int fq) const {
        const int row0 = u.pm * 256 + wr * 64 + fr, col0 = u.pn * 256 + wc * 32 + 8 * fq;
#pragma unroll
        for (int ai = 0; ai < 2; ++ai)
#pragma unroll
            for (int m = 0; m < 4; ++m) {
                const int r = row0 + ai * 128 + m * 16;
                const size_t off = (size_t)r * 1024 + col0;
                const float sc = hs ? rat[(ai * 128 + wr * 64 + m * 16 + fr) * 4 + 3] : 1.0f;
                float ss = 0.f;
#pragma unroll
                for (int bj = 0; bj < 2; ++bj) {
                    const f32x4 b0 = *(const GAS f32x4*)(base + off + bj * 128), b1 = *(const GAS f32x4*)(base + off + bj * 128 + 4);
                    const f32x4 o0 = b0 + acc[ai][bj][m][0] * sc, o1 = b1 + acc[ai][bj][m][1] * sc;
                    *(GAS f32x4*)(out + off + bj * 128) = o0; *(GAS f32x4*)(out + off + bj * 128 + 4) = o1;
                    ss += ((o0[0] * o0[0] + o0[1] * o0[1]) + (o0[2] * o0[2] + o0[3] * o0[3])) + ((o1[0] * o1[0] + o1[1] * o1[1]) + (o1[2] * o1[2] + o1[3] * o1[3]));
                    if (wxb) *(GAS u32x4*)(xb + off + bj * 128) = (u32x4){cvt_pk_bf16(o0[0], o0[1]), cvt_pk_bf16(o0[2], o0[3]), cvt_pk_bf16(o1[0], o1[1]), cvt_pk_bf16(o1[2], o1[3])};
                }
                ss += __shfl_xor(ss, 16); ss += __shfl_xor(ss, 32);
                if (fq == 0) rowss[(size_t)r * 16 + u.pn * 4 + wc] = ss;
            }
    }
};

struct EpiGlu {
    static constexpr bool PERM = true;
    bf16_t* PA; const float* bias;
    __device__ __forceinline__ void operator()(const f32x4 (&acc)[2][2][4][2], const pg8::Unit& u, int wr, int wc, int fr, int fq) const {
        const int row0 = u.pm * 256 + wr * 64 + fr, col0 = u.pn * 256 + wc * 32 + 8 * fq;
        f32x4 bv[2][2];
#pragma unroll
        for (int bj = 0; bj < 2; ++bj)
#pragma unroll
            for (int n = 0; n < 2; ++n) bv[bj][n] = *(const GAS f32x4*)(bias + col0 + bj * 128 + 4 * n);
#pragma unroll
        for (int ai = 0; ai < 2; ++ai)
#pragma unroll
            for (int m = 0; m < 4; ++m) {
                const int r = row0 + ai * 128 + m * 16;
                bf16_t* rowp = PA + (size_t)r * LDP + col0;
#pragma unroll
                for (int bj = 0; bj < 2; ++bj) {
                    const u32x4 yv = *(const GAS u32x4*)(rowp + bj * 128);
                    const u32x4 zv = *(const GAS u32x4*)(rowp + 2048 + bj * 128);
                    const f32x4 s0 = acc[ai][bj][m][0] + bv[bj][0], s1 = acc[ai][bj][m][1] + bv[bj][1];
                    float o[8];
                    const unsigned yw[4] = {yv.x, yv.y, yv.z, yv.w}, zw[4] = {zv.x, zv.y, zv.z, zv.w};
#pragma unroll
                    for (int k = 0; k < 4; ++k) {
                        const float sa = (k < 2) ? s0[2 * k] : s1[2 * k - 4], sb = (k < 2) ? s0[2 * k + 1] : s1[2 * k - 3];
                        const float ya = bflo(yw[k]), yb = bfhi(yw[k]), za = bflo(zw[k]), zb = bfhi(zw[k]);
                        o[2 * k] = ya * sigmoidf_(sa) * (za * sigmoidf_(za));
                        o[2 * k + 1] = yb * sigmoidf_(sb) * (zb * sigmoidf_(zb));
                    }
                    u32x4 w; w.x = cvt_pk_bf16(o[0], o[1]); w.y = cvt_pk_bf16(o[2], o[3]); w.z = cvt_pk_bf16(o[4], o[5]); w.w = cvt_pk_bf16(o[6], o[7]);
                    *(GAS u32x4*)(rowp + 2048 + bj * 128) = w;
                }
            }
    }
};

__device__ __attribute__((noinline)) void convert_wt(LAS unsigned char* lds, const float* W, const float* gain, bf16_t* Wt, int K, int N, int Npad, int wg, int nwg) {
    const int wave = threadIdx.x >> 6, lane = threadIdx.x & 63;
    const int tilesK = K / 16, tilesN = Npad / 64;
    for (int t = wg * 8 + wave; t < tilesK * tilesN; t += nwg * 8) {
        const int k0 = (t % tilesK) * 16, n = (t / tilesK) * 64 + lane;
        const bool ok = n < N;
        const GAS float* src = (const GAS float*)W + (size_t)k0 * N + (ok ? n : 0);
        float v[16];
#pragma unroll
        for (int kk = 0; kk < 16; ++kk) v[kk] = src[(size_t)kk * N];
        if (gain) {
#pragma unroll
            for (int kk = 0; kk < 16; ++kk) v[kk] *= ((const GAS float*)gain)[k0 + kk];
        }
        if (!ok) {
#pragma unroll
            for (int kk = 0; kk < 16; ++kk) v[kk] = 0.f;
        }
        GAS u32x4* dst = (GAS u32x4*)(Wt + (size_t)n * K + k0);
#pragma unroll
        for (int q = 0; q < 2; ++q)
            dst[q] = (u32x4){cvt_pk_bf16(v[8 * q], v[8 * q + 1]), cvt_pk_bf16(v[8 * q + 2], v[8 * q + 3]), cvt_pk_bf16(v[8 * q + 4], v[8 * q + 5]), cvt_pk_bf16(v[8 * q + 6], v[8 * q + 7])};
    }
}

__device__ __attribute__((noinline)) void xprep(const float* x, bf16_t* xb, float* rowss, int wg, int nwg) {
    const int wave = threadIdx.x >> 6, lane = threadIdx.x & 63;
    for (int row = wg * 8 + wave; row < MTOK; row += nwg * 8) {
        const GAS f32x4* xr = (const GAS f32x4*)(x + (size_t)row * 1024);
        float ss = 0.f;
#pragma unroll
        for (int i = 0; i < 4; ++i) {
            const f32x4 v = xr[lane + i * 64];
            ss += (v[0] * v[0] + v[1] * v[1]) + (v[2] * v[2] + v[3] * v[3]);
            u32x2 w; w.x = cvt_pk_bf16(v[0], v[1]); w.y = cvt_pk_bf16(v[2], v[3]);
            *(GAS u32x2*)(xb + (size_t)row * 1024 + (lane + i * 64) * 4) = w;
        }
        ss = wave_sum(ss);
        if (lane < 16) ((GAS float*)rowss)[(size_t)row * 16 + lane] = (lane == 0) ? ss : 0.f;
    }
}

__device__ __attribute__((noinline)) void final_norm(float* out, const float* rowss, const float* gain, int wg, int nwg) {
    const int wave = threadIdx.x >> 6, lane = threadIdx.x & 63;
    for (int row = wg * 8 + wave; row < MTOK; row += nwg * 8) {
        const float rs = row_rs(rowss, row);
        GAS f32x4* xr = (GAS f32x4*)(out + (size_t)row * 1024);
        const GAS f32x4* gp = (const GAS f32x4*)gain;
#pragma unroll
        for (int i = 0; i < 4; ++i) { const f32x4 v = xr[lane + i * 64], g4 = gp[lane + i * 64]; xr[lane + i * 64] = v * rs * g4; }
    }
}

__device__ __attribute__((noinline)) void gla_prep(LAS unsigned char* lds, bf16_t* QK_, bf16_t* KENDT, float* DEC_, const float* wgu_  , const float* bg_  , int wg, int nwg) {
    GAS bf16_t* QK = (GAS bf16_t*)QK_; GAS float* DEC = (GAS float*)DEC_; const GAS float* wgu = (const GAS float*)wgu_; const GAS float* bg = (const GAS float*)bg_;
    const int tid = threadIdx.x, d = tid & 127, sq = tid >> 7;
    LAS float* rS = (LAS float*)lds;
    LAS float* tot = rS + 1024;
    for (int item = wg; item < 1024; item += nwg) {
        const int n = item & 31, h = (item >> 5) & 3, b = item >> 7;
        const size_t m0 = (size_t)b * SEQ + n * 64;
        bf16_t rr[2];
#pragma unroll
        for (int i = 0; i < 2; ++i) { const int idx = tid + i * 512, s = idx >> 4, j = idx & 15; rr[i] = QK[(m0 + s) * 1280 + 1024 + j]; }
        float w[16];
#pragma unroll
        for (int j = 0; j < 16; ++j) w[j] = wgu[j * 512 + h * 128 + d];
        const float bb = bg[h * 128 + d];
        bf16_t qv[16], kv[16];
        GAS bf16_t* qp = QK + (m0 + sq * 16) * 1280 + h * 128 + d;
#pragma unroll
        for (int i = 0; i < 16; ++i) { qv[i] = qp[(size_t)i * 1280]; kv[i] = qp[(size_t)i * 1280 + 512]; }
#pragma unroll
        for (int i = 0; i < 2; ++i) rS[tid + i * 512] = bf2f(rr[i]);
        __syncthreads();
        float c[16]; float run = 0.f;
#pragma unroll
        for (int i = 0; i < 16; ++i) {
            const int s = sq * 16 + i; float g = bb;
#pragma unroll
            for (int j = 0; j < 16; ++j) g += rS[s * 16 + j] * w[j];
            const float la = (fminf(g, 0.f) - __logf(1.0f + __expf(-fabsf(g)))) * (1.0f / 16.0f);
            run += la; c[i] = run;
        }
        tot[sq * 128 + d] = run;
        __syncthreads();
        float off = 0.f, blast = 0.f;
#pragma unroll
        for (int qd = 0; qd < 4; ++qd) { const float t = tot[qd * 128 + d]; blast += t; if (qd < sq) off += t; }
        unsigned ke[8];
#pragma unroll
        for (int i = 0; i < 16; i += 2) {
            float kev[2];
#pragma unroll
            for (int e = 0; e < 2; ++e) {
                const float bc = off + c[i + e];
                const float q = bf2f(qv[i + e]), k = bf2f(kv[i + e]);
                qp[(size_t)(i + e) * 1280] = f2bf(q * __expf(bc) * 0.08838834764831845f);
                qp[(size_t)(i + e) * 1280 + 512] = f2bf(k * __expf(-bc));
                kev[e] = k * __expf(blast - bc);
            }
            ke[i >> 1] = cvt_pk_bf16(kev[0], kev[1]);
        }
        GAS u32x4* kd = (GAS u32x4*)(KENDT + ((size_t)item * 128 + d) * 64 + sq * 16);
        kd[0] = (u32x4){ke[0], ke[1], ke[2], ke[3]}; kd[1] = (u32x4){ke[4], ke[5], ke[6], ke[7]};
        if (sq == 0) DEC[item * 128 + d] = __expf(blast);
        __syncthreads();
    }
}

__device__ __forceinline__ void gla_scan(LAS unsigned char* lds, bf16_t* PA_, const bf16_t* QK_, const bf16_t* KENDT_, const float* DEC_, float* SSQ_, const float* gain_  , int wg, int nwg) {
    GAS bf16_t* PA = (GAS bf16_t*)PA_; const GAS bf16_t* QK = (const GAS bf16_t*)QK_; const GAS bf16_t* KENDT = (const GAS bf16_t*)KENDT_; const GAS float* DEC = (const GAS float*)DEC_; GAS float* SSQ = (GAS float*)SSQ_;
    int tid_ = threadIdx.x; asm volatile("" : "+v"(tid_));
    const int tid = tid_, wave = __builtin_amdgcn_readfirstlane(tid >> 6), lane = tid & 63, fr = lane & 15, fq = lane >> 4;
    LAS bf16_t* Qs = (LAS bf16_t*)lds;
    LAS bf16_t* Ks = (LAS bf16_t*)(lds + 17408);
    LAS bf16_t* KEs = (LAS bf16_t*)(lds + 34816);
    LAS bf16_t* Vt = (LAS bf16_t*)(lds + 53248);
    LAS bf16_t* As = (LAS bf16_t*)(lds + 62464);
    LAS bf16_t* St = (LAS bf16_t*)(lds + 71680);
    LAS float* decs = (LAS float*)(lds + 89088);
    LAS bf16_t* Zs = (LAS bf16_t*)(lds + 89600);
    for (int item = wg; item < 256; item += nwg) {
        const int xq_ = item & 7, iq_ = item >> 3, bh_ = xq_ * 4 + (iq_ >> 3);
        const int vs = iq_ & 7, h = bh_ & 3, b = bh_ >> 2;
        f32x4 S[4];
#pragma unroll
        for (int te = 0; te < 4; ++te) S[te] = (f32x4){0.f, 0.f, 0.f, 0.f};
        for (int i = tid; i < 64 * 136 / 2; i += 512) ((LAS unsigned*)St)[i] = 0u;
        __syncthreads();
        float gq[2][4];
#pragma unroll
        for (int q = 0; q < 2; ++q)
#pragma unroll
            for (int jj = 0; jj < 4; ++jj) gq[q][jj] = ((const GAS float*)gain_)[vs * 64 + ((wave & 1) * 2 + q) * 16 + fq * 4 + jj];
        struct ScanRegs { u32x4 q[2], k[2], e[2], v, z; float d; };
        ScanRegs RA, RB; RA.d = 0.f; RB.d = 0.f;
#define SCAN_LOAD(R, nn) do { const int chunk_ = (b * 4 + h) * 32 + (nn); const size_t m0_ = (size_t)b * SEQ + (nn) * 64; \
            _Pragma("unroll") for (int i = 0; i < 2; ++i) { const int p = tid + i * 512, row = p >> 4, c8 = p & 15; \
                const GAS bf16_t* src = QK + (m0_ + row) * 1280 + h * 128 + c8 * 8; \
                R.q[i] = *(const GAS u32x4*)src; R.k[i] = *(const GAS u32x4*)(src + 512); \
                const int row2 = p >> 3, c82 = p & 7; R.e[i] = *(const GAS u32x4*)(KENDT + ((size_t)chunk_ * 128 + row2) * 64 + c82 * 8); } \
            { const int s = tid >> 3, c8 = tid & 7; const GAS bf16_t* vp = PA + (m0_ + s) * LDP + h * 512 + vs * 64 + c8 * 8; R.v = *(const GAS u32x4*)vp; R.z = *(const GAS u32x4*)(vp + 2048); } \
            if (tid < 128) R.d = DEC[chunk_ * 128 + tid]; } while (0)
#define SCAN_BODY(R, nn) do { \
            const size_t m0 = (size_t)b * SEQ + (nn) * 64; \
_Pragma("unroll") \
            for (int i = 0; i < 2; ++i) { \
                const int p = tid + i * 512, row = p >> 4, c8 = p & 15; \
                *(LAS u32x4*)(Qs + row * 136 + c8 * 8) = R.q[i]; \
                *(LAS u32x4*)(Ks + row * 136 + c8 * 8) = R.k[i]; \
                const int row2 = p >> 3, c82 = p & 7; \
                *(LAS u32x4*)(KEs + row2 * 72 + c82 * 8) = R.e[i]; \
            } \
            { \
                const int s = tid >> 3, c8 = tid & 7; \
                const unsigned vw[4] = {R.v.x, R.v.y, R.v.z, R.v.w}; \
_Pragma("unroll") \
                for (int k = 0; k < 4; ++k) { Vt[(c8 * 8 + 2 * k) * 72 + s] = (bf16_t)(vw[k] & 0xffffu); Vt[(c8 * 8 + 2 * k + 1) * 72 + s] = (bf16_t)(vw[k] >> 16); } \
            } \
            { const int s = tid >> 3, c8 = tid & 7; *(LAS u32x4*)(Zs + s * 72 + c8 * 8) = R.z; } \
            if (tid < 128) decs[tid] = R.d; \
            __syncthreads(); \
            if ((nn) + 2 < 32) SCAN_LOAD(R, (nn) + 2); \
_Pragma("unroll") \
            for (int q = 0; q < 2; ++q) { \
                const int t = wave * 2 + q, tc = t >> 2, ts = t & 3; \
                f32x4 a4 = (f32x4){0.f, 0.f, 0.f, 0.f}; \
_Pragma("unroll") \
                for (int kk = 0; kk < 4; ++kk) { \
                    const bf16x8 ka = *(const LAS bf16x8*)(Ks + (ts * 16 + fr) * 136 + kk * 32 + fq * 8); \
                    const bf16x8 qb = *(const LAS bf16x8*)(Qs + (tc * 16 + fr) * 136 + kk * 32 + fq * 8); \
                    a4 = __builtin_amdgcn_mfma_f32_16x16x32_bf16(ka, qb, a4, 0, 0, 0); \
                } \
                const int c = tc * 16 + fr, s0 = ts * 16 + fq * 4; \
                float v[4]; \
_Pragma("unroll") \
                for (int j = 0; j < 4; ++j) v[j] = (s0 + j <= c) ? a4[j] : 0.f; \
                u32x2 w; w.x = cvt_pk_bf16(v[0], v[1]); w.y = cvt_pk_bf16(v[2], v[3]); \
                *(LAS u32x2*)(As + c * 72 + s0) = w; \
            } \
            __syncthreads(); \
            { \
                const int tc = wave >> 1; float ss = 0.f; \
_Pragma("unroll") \
                for (int q = 0; q < 2; ++q) { \
                    const int te = (wave & 1) * 2 + q; \
                    f32x4 o4 = (f32x4){0.f, 0.f, 0.f, 0.f}; \
_Pragma("unroll") \
                    for (int kk = 0; kk < 2; ++kk) { \
                        const bf16x8 va = *(const LAS bf16x8*)(Vt + (te * 16 + fr) * 72 + kk * 32 + fq * 8); \
                        const bf16x8 ab = *(const LAS bf16x8*)(As + (tc * 16 + fr) * 72 + kk * 32 + fq * 8); \
                        o4 = __builtin_amdgcn_mfma_f32_16x16x32_bf16(va, ab, o4, 0, 0, 0); \
                    } \
_Pragma("unroll") \
                    for (int kk = 0; kk < 4; ++kk) { \
                        const bf16x8 sa = *(const LAS bf16x8*)(St + (te * 16 + fr) * 136 + kk * 32 + fq * 8); \
                        const bf16x8 qb = *(const LAS bf16x8*)(Qs + (tc * 16 + fr) * 136 + kk * 32 + fq * 8); \
                        o4 = __builtin_amdgcn_mfma_f32_16x16x32_bf16(sa, qb, o4, 0, 0, 0); \
                    } \
                    ss += (o4[0] * o4[0] + o4[1] * o4[1]) + (o4[2] * o4[2] + o4[3] * o4[3]); \
                    const u32x2 zz = *(const LAS u32x2*)(Zs + (tc * 16 + fr) * 72 + te * 16 + fq * 4); \
                    const float z0 = bflo(zz.x), z1 = bfhi(zz.x), z2 = bflo(zz.y), z3 = bfhi(zz.y); \
                    u32x2 w; w.x = cvt_pk_bf16(o4[0] * gq[q][0] * (z0 * sigmoidf_(z0)), o4[1] * gq[q][1] * (z1 * sigmoidf_(z1))); \
                    w.y = cvt_pk_bf16(o4[2] * gq[q][2] * (z2 * sigmoidf_(z2)), o4[3] * gq[q][3] * (z3 * sigmoidf_(z3))); \
                    *(GAS u32x2*)(PA + (m0 + tc * 16 + fr) * LDP + h * 512 + vs * 64 + te * 16 + fq * 4) = w; \
                } \
                ss += __shfl_xor(ss, 16); ss += __shfl_xor(ss, 32); \
                if (fq == 0) SSQ[((m0 + tc * 16 + fr) * 4 + h) * 16 + vs * 2 + (wave & 1)] = ss; \
            } \
            { \
                const f32x4 dv = *(const LAS f32x4*)(decs + wave * 16 + fq * 4); \
_Pragma("unroll") \
                for (int te = 0; te < 4; ++te) { \
                    S[te] = S[te] * dv; \
_Pragma("unroll") \
                    for (int kk = 0; kk < 2; ++kk) { \
                        const bf16x8 ka = *(const LAS bf16x8*)(KEs + (wave * 16 + fr) * 72 + kk * 32 + fq * 8); \
                        const bf16x8 vb = *(const LAS bf16x8*)(Vt + (te * 16 + fr) * 72 + kk * 32 + fq * 8); \
                        S[te] = __builtin_amdgcn_mfma_f32_16x16x32_bf16(ka, vb, S[te], 0, 0, 0); \
                    } \
                } \
            } \
            __syncthreads(); \
_Pragma("unroll") \
            for (int te = 0; te < 4; ++te) { \
                u32x2 w; w.x = cvt_pk_bf16(S[te][0], S[te][1]); w.y = cvt_pk_bf16(S[te][2], S[te][3]); \
                *(LAS u32x2*)(St + (te * 16 + fr) * 136 + wave * 16 + fq * 4) = w; \
            } \
        } while (0)
        SCAN_LOAD(RA, 0); SCAN_LOAD(RB, 1);
        for (int n = 0; n < 32; n += 2) {
            SCAN_BODY(RA, n);
            SCAN_BODY(RB, n + 1);
        }
        __syncthreads();
    }
}

__device__ __attribute__((noinline)) void gla_gate(bf16_t* PA_, const float* SSQ_, const float* gain_  , int wg, int nwg) {
    GAS bf16_t* PA = (GAS bf16_t*)PA_; const GAS float* SSQ = (const GAS float*)SSQ_; const GAS float* gain = (const GAS float*)gain_;
    const size_t total = (size_t)MTOK * 256, stride = (size_t)nwg * 512;
    for (size_t p0 = (size_t)wg * 512 + threadIdx.x; p0 < total; p0 += 2 * stride) {
        u32x4 ov[2], zv[2]; f32x4 sv[2]; GAS bf16_t* op[2]; int ee[2];
#pragma unroll
        for (int u = 0; u < 2; ++u) {
            const size_t p = p0 + u * stride; const bool ok = p < total; const size_t pp = ok ? p : p0;
            const size_t m = pp >> 8; const int col = (int)(pp & 255) * 8, h = col >> 9; ee[u] = col & 511;
            const GAS f32x4* sp = (const GAS f32x4*)(SSQ + (m * 4 + h) * 16);
            sv[u] = (sp[0] + sp[1]) + (sp[2] + sp[3]);
            op[u] = ok ? PA + m * LDP + col : nullptr;
            ov[u] = *(const GAS u32x4*)(PA + m * LDP + col); zv[u] = *(const GAS u32x4*)(PA + m * LDP + col + 2048);
        }
#pragma unroll
        for (int u = 0; u < 2; ++u) {
            const f32x4 s = sv[u];
            const float rs = rsqrtf(((s[0] + s[1]) + (s[2] + s[3])) * (1.0f / 512.0f) + EPS);
            const f32x4 g0 = *(const GAS f32x4*)(gain + ee[u]), g1 = *(const GAS f32x4*)(gain + ee[u] + 4);
            const unsigned ow[4] = {ov[u].x, ov[u].y, ov[u].z, ov[u].w}, zw[4] = {zv[u].x, zv[u].y, zv[u].z, zv[u].w};
            const float gg[8] = {g0[0], g0[1], g0[2], g0[3], g1[0], g1[1], g1[2], g1[3]};
            unsigned r[4];
#pragma unroll
            for (int k = 0; k < 4; ++k) {
                const float oa = bflo(ow[k]), ob = bfhi(ow[k]), za = bflo(zw[k]), zb = bfhi(zw[k]);
                r[k] = cvt_pk_bf16(oa * rs * gg[2 * k] * (za * sigmoidf_(za)), ob * rs * gg[2 * k + 1] * (zb * sigmoidf_(zb)));
            }
            if (op[u]) *(u32x4*)op[u] = (u32x4){r[0], r[1], r[2], r[3]};
        }
    }
}

__device__ __forceinline__ float gelu_tanh(float y) { return y * sigmoidf_(1.5957691216057308f * (y + 0.044715f * y * y * y)); }

__device__ __attribute__((noinline)) void s5_tables(LAS unsigned char* lds, bf16_t* BtY, bf16_t* BtF, float* L16, const float* lam_re_, const float* lam_im_, const float* log_dt_,
                                                    const float* b_re_, const float* b_im_, const float* c_re_, const float* c_im_, const float* dsk_, int wg, int nwg) {
    const GAS float* lam_re = (const GAS float*)lam_re_; const GAS float* lam_im = (const GAS float*)lam_im_; const GAS float* log_dt = (const GAS float*)log_dt_;
    const GAS float* b_re = (const GAS float*)b_re_; const GAS float* b_im = (const GAS float*)b_im_; const GAS float* c_re = (const GAS float*)c_re_; const GAS float* c_im = (const GAS float*)c_im_; const GAS float* dsk = (const GAS float*)dsk_;
    const int tid = threadIdx.x;
    LAS float* Bb = (LAS float*)lds;
    LAS float* Cc = Bb + 2048;
    LAS float* Pw = Cc + 2048;
    LAS float* Kl = Pw + 2176;
    for (int item = wg; item < 256; item += nwg) {
        const int g = item >> 1, half = item & 1;
        const float dt = expf(log_dt[g]);
        for (int idx = tid; idx < 17 * 64; idx += 512) {
            const int d = idx >> 6, p = idx & 63;
            const float lr = lam_re[g * 64 + p], li = lam_im[g * 64 + p];
            const float mag = expf((float)d * lr * dt), ang = (float)d * (li * dt);
            Pw[idx * 2] = mag * cosf(ang); Pw[idx * 2 + 1] = mag * sinf(ang);
        }
        for (int idx = tid; idx < 1024; idx += 512) {
            const int p = idx >> 4, jj = idx & 15;
            const float lr = lam_re[g * 64 + p], li = lam_im[g * 64 + p];
            const float mag = expf(lr * dt), ang = li * dt, lbr = mag * cosf(ang), lbi = mag * sinf(ang);
            const float nr = lbr - 1.0f, ni = lbi, den = lr * lr + li * li;
            const float bcr = (nr * lr + ni * li) / den, bci = (ni * lr - nr * li) / den;
            const float xr = b_re[(size_t)(g * 64 + p) * 16 + jj], xi = b_im[(size_t)(g * 64 + p) * 16 + jj];
            Bb[idx * 2] = bcr * xr - bci * xi; Bb[idx * 2 + 1] = bcr * xi + bci * xr;
            const int i = idx >> 6, pp = idx & 63;
            Cc[idx * 2] = c_re[(size_t)(g * 16 + i) * 64 + pp]; Cc[idx * 2 + 1] = c_im[(size_t)(g * 16 + i) * 64 + pp];
        }
        __syncthreads();
        if (half == 0 && tid < 128) ((GAS float*)L16)[g * 128 + tid] = Pw[16 * 128 + tid];
        {
            const int ij = tid & 255, i = ij >> 4, jj = ij & 15, dh = tid >> 8;
            float acc[8];
#pragma unroll
            for (int e = 0; e < 8; ++e) acc[e] = 0.f;
            for (int p = 0; p < 64; ++p) {
                const float cr = Cc[(i * 64 + p) * 2], ci = Cc[(i * 64 + p) * 2 + 1], br = Bb[(p * 16 + jj) * 2], bi = Bb[(p * 16 + jj) * 2 + 1];
                const float u = cr * br - ci * bi, v = ci * br + cr * bi;
#pragma unroll
                for (int e = 0; e < 8; ++e) { const int d = dh + 2 * e; acc[e] += Pw[(d * 64 + p) * 2] * u - Pw[(d * 64 + p) * 2 + 1] * v; }
            }
#pragma unroll
            for (int e = 0; e < 8; ++e) Kl[(dh + 2 * e) * 256 + ij] = acc[e];
        }
        __syncthreads();
        for (int idx = tid; idx < 128 * 128; idx += 512) {
            const int rl = idx >> 7, kp = idx & 127, t = half * 8 + (rl >> 4), i = rl & 15, k = 2 * kp, s = k >> 4, jj = k & 15;
            float v0 = 0.f, v1 = 0.f;
            if (s <= t) { v0 = Kl[(t - s) * 256 + i * 16 + jj]; v1 = Kl[(t - s) * 256 + i * 16 + jj + 1];
                if (s == t) { if (i == jj) v0 += dsk[g * 16 + i]; if (i == jj + 1) v1 += dsk[g * 16 + i]; } }
            *(GAS unsigned*)(BtY + ((size_t)g * 256 + t * 16 + i) * 384 + k) = cvt_pk_bf16(v0, v1);
        }
        for (int idx = tid; idx < 128 * 64; idx += 512) {
            const int rl = idx >> 6, kp = idx & 63, t = half * 8 + (rl >> 4), i = rl & 15, k2 = 2 * kp, part = k2 >> 6, p = k2 & 63;
            float v[2];
#pragma unroll
            for (int e = 0; e < 2; ++e) {
                const float cr = Cc[(i * 64 + p + e) * 2], ci = Cc[(i * 64 + p + e) * 2 + 1], pr = Pw[((t + 1) * 64 + p + e) * 2], pi = Pw[((t + 1) * 64 + p + e) * 2 + 1];
                v[e] = part == 0 ? (cr * pr - ci * pi) : -(cr * pi + ci * pr);
            }
            *(GAS unsigned*)(BtY + ((size_t)g * 256 + t * 16 + i) * 384 + 256 + k2) = cvt_pk_bf16(v[0], v[1]);
        }
        for (int idx = tid; idx < 64 * 128; idx += 512) {
            const int p = idx >> 7, kp = idx & 127, k = 2 * kp, s = k >> 4, jj = k & 15;
            const float pr = Pw[((15 - s) * 64 + p) * 2], pi = Pw[((15 - s) * 64 + p) * 2 + 1];
            float v[2];
#pragma unroll
            for (int e = 0; e < 2; ++e) { const float br = Bb[(p * 16 + jj + e) * 2], bi = Bb[(p * 16 + jj + e) * 2 + 1]; v[e] = half == 0 ? (pr * br - pi * bi) : (pr * bi + pi * br); }
            *(GAS unsigned*)(BtF + ((size_t)g * 128 + half * 64 + p) * 256 + k) = cvt_pk_bf16(v[0], v[1]);
        }
        __syncthreads();
    }
}

__device__ __attribute__((noinline)) void s5_ssm(LAS unsigned char* lds, bf16_t* PA_, const bf16_t* BtY_, const bf16_t* BtF_, const float* L16_, int wg, int nwg) {
    GAS bf16_t* PA = (GAS bf16_t*)PA_; const GAS bf16_t* BtY = (const GAS bf16_t*)BtY_; const GAS bf16_t* BtF = (const GAS bf16_t*)BtF_;
    const GAS float* L16 = (const GAS float*)L16_;
    const int tid = threadIdx.x, wave = __builtin_amdgcn_readfirstlane(tid >> 6), lane = tid & 63, fr = lane & 15, fq = lane >> 4;
    LAS bf16_t* Us = (LAS bf16_t*)lds;
    LAS bf16_t* Fs = (LAS bf16_t*)(lds + 67584);
    for (int item = wg * 4; item < 1024; item += nwg * 4)
#pragma unroll 1
    for (int sub = 0; sub < 4; ++sub) {
        const int b = (item >> 2) & 7, g = (item >> 5) * 4 + sub;
#pragma unroll
        for (int hb = 0; hb < 2; ++hb) {
            u32x4 uv[4];
#pragma unroll
            for (int r = 0; r < 4; ++r) { const int q = tid + (hb * 4 + r) * 512, tl = q >> 1, hf = q & 1; uv[r] = *(const GAS u32x4*)(PA + ((size_t)b * SEQ + tl) * LDP + g * 16 + hf * 8); }
#pragma unroll
            for (int r = 0; r < 4; ++r) { const int q = tid + (hb * 4 + r) * 512, tl = q >> 1, hf = q & 1, c = tl >> 4, s = tl & 15; *(LAS u32x4*)(Us + c * 264 + s * 16 + hf * 8) = uv[r]; }
        }
        bf16x8 bf[8];
#pragma unroll
        for (int kk = 0; kk < 8; ++kk) bf[kk] = *(const GAS bf16x8*)(BtF + ((size_t)g * 128 + wave * 16 + fr) * 256 + kk * 32 + fq * 8);
        __syncthreads();
#pragma unroll 2
        for (int mt = 0; mt < 8; ++mt) {
            f32x4 a4 = (f32x4){0.f, 0.f, 0.f, 0.f};
#pragma unroll
            for (int kk = 0; kk < 8; ++kk) {
                const bf16x8 ua = *(const LAS bf16x8*)(Us + (mt * 16 + fr) * 264 + kk * 32 + fq * 8);
                a4 = __builtin_amdgcn_mfma_f32_16x16x32_bf16(bf[kk], ua, a4, 0, 0, 0);
            }
            u32x2 w; w.x = cvt_pk_bf16(a4[0], a4[1]); w.y = cvt_pk_bf16(a4[2], a4[3]);
            *(LAS u32x2*)(Fs + (mt * 16 + fr) * 136 + wave * 16 + fq * 4) = w;
        }
        __syncthreads();
        if (tid < 64) {
            const int p = tid;
            const float l16r = L16[g * 128 + 2 * p], l16i = L16[g * 128 + 2 * p + 1];
            float sr = 0.f, si = 0.f;
            for (int c0 = 0; c0 < 128; c0 += 8) {
                float fre[8], fim[8];
#pragma unroll
                for (int e = 0; e < 8; ++e) { fre[e] = bf2f(Fs[(c0 + e) * 136 + p]); fim[e] = bf2f(Fs[(c0 + e) * 136 + 64 + p]); }
#pragma unroll
                for (int e = 0; e < 8; ++e) {
                    Fs[(c0 + e) * 136 + p] = f2bf(sr); Fs[(c0 + e) * 136 + 64 + p] = f2bf(si);
                    const float nsr = l16r * sr - l16i * si + fre[e], nsi = l16r * si + l16i * sr + fim[e];
                    sr = nsr; si = nsi;
                }
            }
        }
        __syncthreads();
#pragma unroll 1
        for (int q = 0; q < 2; ++q) {
            const int t = q == 0 ? wave : 15 - wave, nks = (t >> 1) + 1;
            const GAS bf16_t* brow = BtY + ((size_t)g * 256 + t * 16 + fr) * 384 + fq * 8;
            bf16x8 b0[4], bs[4], b1[4];
#pragma unroll
            for (int kk = 0; kk < 4; ++kk) bs[kk] = *(const GAS bf16x8*)(brow + 256 + kk * 32);
#pragma unroll
            for (int kk = 0; kk < 4; ++kk) b0[kk] = *(const GAS bf16x8*)(brow + kk * 32);
#pragma unroll
            for (int kk = 0; kk < 4; ++kk) b1[kk] = *(const GAS bf16x8*)(brow + (4 + kk) * 32);
#pragma unroll 1
            for (int mh = 0; mh < 2; ++mh) {
                f32x4 acc[4];
#pragma unroll
                for (int m = 0; m < 4; ++m) acc[m] = (f32x4){0.f, 0.f, 0.f, 0.f};
                const LAS bf16_t* fsb = Fs + (mh * 64 + fr) * 136 + fq * 8;
                const LAS bf16_t* usb = Us + (mh * 64 + fr) * 264 + fq * 8;
#pragma unroll
                for (int kk = 0; kk < 4; ++kk) {
#pragma unroll
                    for (int m = 0; m < 4; ++m) {
                        const bf16x8 ua = *(const LAS bf16x8*)(fsb + m * 16 * 136 + kk * 32);
                        acc[m] = __builtin_amdgcn_mfma_f32_16x16x32_bf16(bs[kk], ua, acc[m], 0, 0, 0);
                    }
                }
#pragma unroll
                for (int kk = 0; kk < 4; ++kk) {
                    if (kk < nks) {
#pragma unroll
                        for (int m = 0; m < 4; ++m) {
                            const bf16x8 ua = *(const LAS bf16x8*)(usb + m * 16 * 264 + kk * 32);
                            acc[m] = __builtin_amdgcn_mfma_f32_16x16x32_bf16(b0[kk], ua, acc[m], 0, 0, 0);
                        }
                    }
                }
#pragma unroll
                for (int kk = 0; kk < 4; ++kk) {
                    if (4 + kk < nks) {
#pragma unroll
                        for (int m = 0; m < 4; ++m) {
                            const bf16x8 ua = *(const LAS bf16x8*)(usb + m * 16 * 264 + (4 + kk) * 32);
                            acc[m] = __builtin_amdgcn_mfma_f32_16x16x32_bf16(b1[kk], ua, acc[m], 0, 0, 0);
                        }
                    }
                }
#pragma unroll
                for (int m = 0; m < 4; ++m) {
                    const int mt = mh * 4 + m;
                    u32x2 w; w.x = cvt_pk_bf16(gelu_tanh(acc[m][0]), gelu_tanh(acc[m][1])); w.y = cvt_pk_bf16(gelu_tanh(acc[m][2]), gelu_tanh(acc[m][3]));
                    *(GAS u32x2*)(PA + ((size_t)b * SEQ + (mt * 16 + fr) * 16 + t) * LDP + g * 16 + fq * 4) = w;
                }
            }
        }
        __syncthreads();
    }
}


__device__ __attribute__((noinline)) void gla_rat(LAS unsigned char* lds, const float* SSQ_, int pm) {
    const GAS float* SSQ = (const GAS float*)SSQ_;
    LAS float* rt = (LAS float*)(lds + RAT_OFF);
    for (int idx = threadIdx.x; idx < 1024; idx += 512) {
        const int row = idx >> 2, hh = idx & 3;
        const GAS f32x4* sp = (const GAS f32x4*)(SSQ + ((size_t)(pm * 256 + row) * 4 + hh) * 16);
        const f32x4 s4 = (sp[0] + sp[1]) + (sp[2] + sp[3]);
        rt[idx] = rsqrtf(((s4[0] + s4[1]) + (s4[2] + s4[3])) * (1.0f / 512.0f) + EPS);
    }
    __syncthreads();
    if (threadIdx.x < 256) { const int row = threadIdx.x; const float r0 = rt[row * 4], r1 = rt[row * 4 + 1], r2 = rt[row * 4 + 2], r3 = rt[row * 4 + 3];
        rt[row * 4] = r0 / r1; rt[row * 4 + 1] = r1 / r2; rt[row * 4 + 2] = r2 / r3; rt[row * 4 + 3] = r3; }
    __syncthreads();
}

struct Params { const float* in[21]; float* out; unsigned char* ws; };

__global__ void __launch_bounds__(512, 2) fwd_megakernel(Params P) {
    extern __shared__ __attribute__((aligned(16))) unsigned char lds_raw[];
    LAS unsigned char* lds = (LAS unsigned char*)lds_raw;
    cg::grid_group grid = cg::this_grid();
    volatile LAS unsigned* xst = (volatile LAS unsigned*)(lds + 131072);
    if (threadIdx.x < 4) xst[threadIdx.x] = 0u;
    __syncthreads();
    unsigned* barw = (unsigned*)(P.ws + WS_BAR);
    const XcdBarrier xb = xcd_barrier_post(barw, xst);
#define GSYNC() xcd_barrier(xb.bar, xb.x, xb.st)
#ifdef PROBE_CLASS
    unsigned long long pt0 = __builtin_amdgcn_s_memrealtime(), pacc = 0ull;
#define STAMP(cls) do { const unsigned long long _t = __builtin_amdgcn_s_memrealtime(); if ((cls) == PROBE_CLASS) pacc += _t - pt0; pt0 = _t; } while (0)
#else
#define STAMP(cls) do {} while (0)
#endif
    const int wg = blockIdx.x, nwg = gridDim.x;
    unsigned char* ws = P.ws;
    bf16_t* WGLA_IN = (bf16_t*)(ws + WS_WGLA_IN); bf16_t* WGLA_OUT = (bf16_t*)(ws + WS_WGLA_OUT);
    bf16_t* WS5_IN = (bf16_t*)(ws + WS_WS5_IN); bf16_t* WS5_GLU = (bf16_t*)(ws + WS_WS5_GLU); bf16_t* WS5_OUT = (bf16_t*)(ws + WS_WS5_OUT);
    bf16_t* XB = (bf16_t*)(ws + WS_XB); bf16_t* KENDT = XB;
    bf16_t* PA = (bf16_t*)(ws + WS_PA); bf16_t* QK = (bf16_t*)(ws + WS_QK);
    bf16_t* BTY = (bf16_t*)(ws + WS_BTY); bf16_t* BTF = (bf16_t*)(ws + WS_BTF);
    float* RSS = (float*)(ws + WS_RSS); float* DEC = (float*)(ws + WS_DEC); float* SSQ = (float*)(ws + WS_SSQ);
    const float* x = P.in[0];
    float* out = P.out;

    convert_wt(lds, P.in[2], P.in[1], WGLA_IN, 1024, GLA_IN, GLA_NP, wg, nwg);
    convert_wt(lds, P.in[6], nullptr, WGLA_OUT, 2048, 1024, 1024, wg, nwg);
    convert_wt(lds, P.in[8], P.in[7], WS5_IN, 1024, 4096, 4096, wg, nwg);
    convert_wt(lds, P.in[17], nullptr, WS5_GLU, 2048, 2048, 2048, wg, nwg);
    convert_wt(lds, P.in[19], nullptr, WS5_OUT, 2048, 1024, 1024, wg, nwg);
    xprep(x, XB, RSS, wg, nwg);
    GSYNC();
    STAMP(0);

    for (int layer = 0; layer < 4; ++layer) {
        const int j = layer >> 1;
        const bool is_s5 = (layer & 1) != 0;
        const float* resid = (layer == 0) ? x : out;
        if (is_s5)
            s5_tables(lds, BTY, BTF, (float*)(ws + WS_L16), P.in[9] + (size_t)j * 128 * 64, P.in[10] + (size_t)j * 128 * 64, P.in[11] + (size_t)j * 128,
                      P.in[12] + (size_t)j * 128 * 64 * 16, P.in[13] + (size_t)j * 128 * 64 * 16,
                      P.in[14] + (size_t)j * 128 * 16 * 64, P.in[15] + (size_t)j * 128 * 16 * 64, P.in[16] + (size_t)j * 128 * 16, wg, nwg);
        { pg8::Gemm g{XB, is_s5 ? WS5_IN : WGLA_IN, MTOK, is_s5 ? 4096 : GLA_NP, 1024, 1024}; pg8::StaticOrder S; S.init(MTOK, g.N, nwg, wg);
          EpiProj E{PA, QK, RSS, is_s5 ? 0 : 4, is_s5 ? 16 : 20}; pg8::gemm_phase<EpiProj, true>(lds, g, S, E); }
        if (layer == 2) {
            const int first = (nwg > 128) ? 64 : 0;
            if (wg >= first) {
                convert_wt(lds, P.in[8] + (size_t)1024 * 4096, P.in[7] + 1024, WS5_IN, 1024, 4096, 4096, wg - first, nwg - first);
                convert_wt(lds, P.in[17] + (size_t)2048 * 2048, nullptr, WS5_GLU, 2048, 2048, 2048, wg - first, nwg - first);
                convert_wt(lds, P.in[19] + (size_t)2048 * 1024, nullptr, WS5_OUT, 2048, 1024, 1024, wg - first, nwg - first);
            }
        }
        GSYNC();
        STAMP(1);
        if (!is_s5) {
            gla_prep(lds, QK, KENDT, DEC, P.in[3] + (size_t)j * 16 * 512, P.in[4] + (size_t)j * 512, wg, nwg);
            GSYNC();
            STAMP(2);
            gla_scan(lds, PA, QK, KENDT, DEC, SSQ, P.in[5] + (size_t)j * 512, wg, nwg);
            GSYNC();
            STAMP(3);
        } else {
            if (layer == 1) {
                convert_wt(lds, P.in[2] + (size_t)1024 * GLA_IN, P.in[1] + 1024, WGLA_IN, 1024, GLA_IN, GLA_NP, wg, nwg);
                convert_wt(lds, P.in[6] + (size_t)2048 * 1024, nullptr, WGLA_OUT, 2048, 1024, 1024, wg, nwg);
            }
            s5_ssm(lds, PA, BTY, BTF, (const float*)(ws + WS_L16), wg, nwg);
            GSYNC();
            STAMP(6);
            { pg8::Gemm g{PA, WS5_GLU, MTOK, 2048, 2048, LDP}; pg8::StaticOrder S; S.init(MTOK, 2048, nwg, wg);
              EpiGlu E{PA, P.in[18] + (size_t)j * 2048}; pg8::gemm_phase<EpiGlu, true>(lds, g, S, E); }
            GSYNC();
            STAMP(7);
        }
        { pg8::Gemm g{is_s5 ? PA + 2048 : PA, is_s5 ? WS5_OUT : WGLA_OUT, MTOK, 1024, 2048, LDP}; pg8::StaticOrder S; S.init(MTOK, 1024, nwg, wg);
          if (!is_s5) { pg8::Unit u0; u0.pm = 0; u0.pn = 0; S.next(0, u0); gla_rat(lds, SSQ, u0.pm); }
          EpiOut E{resid, out, XB, RSS, (const LAS float*)(lds + RAT_OFF), !is_s5, layer != 3}; pg8::gemm_phase<EpiOut, true>(lds, g, S, E, !is_s5); }
        GSYNC();
        STAMP(5);
    }
    final_norm(out, RSS, P.in[20], wg, nwg);
    if (P.ws == nullptr) grid.sync();
#ifdef PROBE_CLASS
    if (wg == 0) { const unsigned long long te = __builtin_amdgcn_s_memrealtime(); while (__builtin_amdgcn_s_memrealtime() - te < pacc) __builtin_amdgcn_s_sleep(8); }
#endif
}

extern "C" void kernel_launch(void* const* d_in, const int* in_sizes, int n_in, void* d_out, int out_size, void* d_ws, size_t ws_size, hipStream_t stream) {
    static int grid_blocks = 0;
    if (!grid_blocks) {
        int dev = 0, cus = 0, per_cu = 0;
        (void)hipGetDevice(&dev);
        (void)hipDeviceGetAttribute(&cus, hipDeviceAttributeMultiprocessorCount, dev);
        (void)hipFuncSetAttribute((const void*)fwd_megakernel, hipFuncAttributeMaxDynamicSharedMemorySize, LDS_BYTES);
        (void)hipOccupancyMaxActiveBlocksPerMultiprocessor(&per_cu, (const void*)fwd_megakernel, 512, LDS_BYTES);
        if (per_cu < 1) { fprintf(stderr, "occupancy query returned %d\n", per_cu); per_cu = 1; }
        if (per_cu > 1) per_cu = 1;
        grid_blocks = cus * per_cu;
        if (ws_size < WS_END) fprintf(stderr, "workspace too small: %zu < %zu\n", ws_size, (size_t)WS_END);
    }
    (void)hipMemsetAsync((char*)d_ws + WS_BAR, 0, 16384, stream);
    Params p{};
    for (int i = 0; i < 21; ++i) p.in[i] = (const float*)d_in[i];
    p.out = (float*)d_out; p.ws = (unsigned char*)d_ws;
    void* args[] = {&p};
    hipError_t e = hipLaunchCooperativeKernel((void*)fwd_megakernel, dim3(grid_blocks), dim3(512), args, LDS_BYTES, stream);
    if (e != hipSuccess) fprintf(stderr, "cooperative launch failed: %s (grid %d)\n", hipGetErrorString(e), grid_blocks);
}
```
